# Optimizing an MI355X kernel written in HIP

```python
import jax, jax.numpy as jnp
from jax import lax
import numpy as np

D_MODEL = 1024
BATCH = 8
SEQ = 4096
DEPTH = 1
DEC_BATCH = 8
DEC_SEQ = 16
PAST_LEN = 4096

CHUNK = 64
Q_BLOCK = 128
HG_HEADS = 4
HG_DK = 128
HG_DV = 128
MLA_HEADS = 4
MLA_NOPE = 128
MLA_ROPE = 64
MLA_V = 128
Q_LORA = 384
KV_LORA = 256
ROPE_THETA = 10000.0
MLA_SCALE = (MLA_NOPE + MLA_ROPE) ** -0.5
MIX_WIDTH = HG_HEADS * HG_DV + MLA_HEADS * MLA_V
IN_WIDTH = 2 * HG_HEADS * HG_DK + 2 * HG_HEADS * HG_DV + Q_LORA + KV_LORA + MLA_ROPE
D_FF = 2816
CONV_W = 3
EPS = 1e-6

kernel_name = 'hymba_hgrn2_mla_convglu_adaln_stream_step'


def rmsnorm(x, gain):
    xf = x.astype(jnp.float32)
    y = xf * lax.rsqrt(jnp.mean(xf * xf, axis=-1, keepdims=True) + EPS)
    return (y * gain.astype(jnp.float32)).astype(x.dtype)


def rope(x, pos):
    half = x.shape[-1] // 2
    inv_freq = ROPE_THETA ** (-jnp.arange(half, dtype=jnp.float32) / half)
    ang = pos.astype(jnp.float32)[:, None] * inv_freq[None, :]
    cos = jnp.cos(ang)[None, :, None, :]
    sin = jnp.sin(ang)[None, :, None, :]
    xf = x.astype(jnp.float32)
    x1, x2 = xf[..., :half], xf[..., half:]
    return jnp.concatenate([x1 * cos - x2 * sin, x2 * cos + x1 * sin], axis=-1).astype(x.dtype)


def hgrn_chunk(s0, q, k, v, logf):
    L = q.shape[1]
    b = jnp.cumsum(logf, axis=1)
    causal = jnp.tril(jnp.ones((L, L), dtype=bool))
    diff = b[:, :, None] - b[:, None, :]
    decay = jnp.exp(jnp.where(causal[None, :, :, None, None], diff, -jnp.inf))
    scores = jnp.einsum('bthk,bshk,btshk->bhts', q, k, decay)
    o = (jnp.einsum('bthk,bhkv->bthv', q * jnp.exp(b), s0)
         + jnp.einsum('bhts,bshv->bthv', scores, v))
    b_last = b[:, -1]
    s_new = (jnp.exp(b_last)[..., None] * s0
             + jnp.einsum('bshk,bshv->bhkv', k * jnp.exp(b_last[:, None] - b), v))
    return s_new, o


def hgrn_prompt(q, k, v, logf):
    B, S = q.shape[:2]
    nc = S // CHUNK

    def to_chunks(t):
        return t.reshape(B, nc, CHUNK, *t.shape[2:]).swapaxes(0, 1)

    s0 = jnp.zeros((B, HG_HEADS, HG_DK, HG_DV), jnp.float32)
    s_final, o = lax.scan(lambda s, xs: hgrn_chunk(s, *xs), s0,
                          (to_chunks(q), to_chunks(k), to_chunks(v), to_chunks(logf)))
    return s_final, o.swapaxes(0, 1).reshape(B, S, HG_HEADS, HG_DV)


def hgrn_mixer(hq, hf, hi, hg, lb, gain, state):
    B, L = hq.shape[:2]
    dt = hq.dtype
    f32 = jnp.float32
    q = hq.astype(f32).reshape(B, L, HG_HEADS, HG_DK) * HG_DK ** -0.5
    f = lb + (1.0 - lb) * jax.nn.sigmoid(hf.astype(f32))
    k = (1.0 - f).reshape(B, L, HG_HEADS, HG_DK)
    logf = jnp.log(f).reshape(B, L, HG_HEADS, HG_DK)
    v = hi.astype(f32).reshape(B, L, HG_HEADS, HG_DV)
    if state is None:
        s_new, o = hgrn_prompt(q, k, v, logf)
    else:
        s_new, o = hgrn_chunk(state.astype(f32), q, k, v, logf)
    o = o * lax.rsqrt(jnp.mean(o * o, axis=-1, keepdims=True) + EPS) * gain.astype(f32)
    o = o.reshape(B, L, HG_HEADS * HG_DV) * jax.nn.silu(hg.astype(f32))
    return o.astype(dt), s_new.astype(dt)


def attend(q_nope, q_pe, k_nope, k_pe, v, mask):
    s = (jnp.einsum('bqhd,bkhd->bhqk', q_nope, k_nope)
         + jnp.einsum('bqhr,bkr->bhqk', q_pe, k_pe)).astype(jnp.float32) * MLA_SCALE
    if mask is not None:
        s = jnp.where(mask, s, -jnp.inf)
    p = jax.nn.softmax(s, axis=-1).astype(v.dtype)
    return jnp.einsum('bhqk,bkhd->bqhd', p, v)


def chunk_causal_attention(q_nope, q_pe, k_nope, k_pe, v):
    B, L = q_nope.shape[:2]
    nb = L // Q_BLOCK
    key_chunk = jnp.arange(L) // CHUNK

    def blocks(t):
        return t.reshape(B, nb, Q_BLOCK, *t.shape[2:]).swapaxes(0, 1)

    def one_block(xs):
        qn, qp, bi = xs
        q_chunk = (bi * Q_BLOCK + jnp.arange(Q_BLOCK)) // CHUNK
        mask = key_chunk[None, :] <= q_chunk[:, None]
        return attend(qn, qp, k_nope, k_pe, v, mask[None, None])

    o = lax.map(one_block, (blocks(q_nope), blocks(q_pe), jnp.arange(nb)))
    return o.swapaxes(0, 1).reshape(B, L, MLA_HEADS, MLA_V)


def mla_mixer(hcq, hckv, hkpe, pos, qn_g, kvn_g, w_uq, w_uk, w_uv, cache_lat, cache_kpe):
    B, L = hcq.shape[:2]
    q = (rmsnorm(hcq, qn_g) @ w_uq).reshape(B, L, MLA_HEADS, MLA_NOPE + MLA_ROPE)
    q_nope = q[..., :MLA_NOPE]
    q_pe = rope(q[..., MLA_NOPE:], pos)
    lat = rmsnorm(hckv, kvn_g)
    kpe = rope(hkpe[:, :, None, :], pos)[:, :, 0, :]
    if cache_lat is None:
        k_lat, k_pe_all = lat, kpe
    else:
        k_lat = jnp.concatenate([cache_lat.astype(lat.dtype), lat], axis=1)
        k_pe_all = jnp.concatenate([cache_kpe.astype(kpe.dtype), kpe], axis=1)
    k_nope = jnp.einsum('bkc,chd->bkhd', k_lat, w_uk)
    v = jnp.einsum('bkc,chd->bkhd', k_lat, w_uv)
    if cache_lat is None:
        o = chunk_causal_attention(q_nope, q_pe, k_nope, k_pe_all, v)
    else:
        o = attend(q_nope, q_pe, k_nope, k_pe_all, v, None)
    return o.reshape(B, L, MLA_HEADS * MLA_V), lat, kpe


def conv_glu(h, w_up, conv_w, conv_b, w_down, buf):
    B, L = h.shape[:2]
    a, v = jnp.split(h @ w_up, 2, axis=-1)
    if buf is None:
        buf = jnp.zeros((B, CONV_W - 1, D_FF), a.dtype)
    ext = jnp.concatenate([buf.astype(a.dtype), a], axis=1)
    conv = conv_b + sum(conv_w[j] * ext[:, j:j + L] for j in range(CONV_W))
    out = (jax.nn.gelu(conv, approximate=False) * v) @ w_down
    return out, ext[:, L:]


def trunk_layer(x, c, pos, w, cache_lat, cache_kpe, st_hg, st_conv):
    (w_ada, b_ada, g_mix, w_in, lb, hg_g, qn_g, kvn_g, w_uq, w_uk, w_uv, w_out,
     g_ffn, w_up, conv_w, conv_b, w_down) = w
    mod = (jax.nn.silu(c) @ w_ada + b_ada)[:, None, :]
    sh1, sc1, g1, sh2, sc2, g2 = jnp.split(mod, 6, axis=-1)
    h = rmsnorm(x, g_mix) * (1.0 + sc1) + sh1
    proj = h @ w_in
    qk = HG_HEADS * HG_DK
    vw = HG_HEADS * HG_DV
    points = [qk, 2 * qk, 2 * qk + vw, 2 * qk + 2 * vw,
              2 * qk + 2 * vw + Q_LORA, 2 * qk + 2 * vw + Q_LORA + KV_LORA]
    hq, hf, hi, hg, hcq, hckv, hkpe = jnp.split(proj, points, axis=-1)
    o_hg, st_hg_new = hgrn_mixer(hq, hf, hi, hg, lb, hg_g, st_hg)
    o_mla, lat_new, kpe_new = mla_mixer(hcq, hckv, hkpe, pos, qn_g, kvn_g, w_uq, w_uk, w_uv,
                                        cache_lat, cache_kpe)
    x = x + g1 * (jnp.concatenate([o_hg, o_mla], axis=-1) @ w_out)
    h2 = rmsnorm(x, g_ffn) * (1.0 + sc2) + sh2
    f, conv_new = conv_glu(h2, w_up, conv_w, conv_b, w_down, st_conv)
    x = x + g2 * f
    return x, lat_new, kpe_new, st_hg_new, conv_new


def setup_inputs(seed: int = 0) -> dict:
    key = jax.random.key(seed)
    ks = jax.random.split(key, 26)
    D = D_MODEL
    L = DEPTH

    def nrm(k, shape, scale):
        return jax.random.normal(k, shape, jnp.float32) * scale

    return {
        'x_prompt': nrm(ks[0], (BATCH, SEQ, D), 1.0),
        'x_sample': nrm(ks[1], (DEC_BATCH, DEC_SEQ, D), 1.0),
        'c_prompt': nrm(ks[2], (BATCH, D), 1.0),
        'c_sample': nrm(ks[3], (DEC_BATCH, D), 1.0),
        'cache_kv_latent': nrm(ks[4], (L, DEC_BATCH, PAST_LEN, KV_LORA), 1.0),
        'cache_k_rope': nrm(ks[5], (L, DEC_BATCH, PAST_LEN, MLA_ROPE), 1.0),
        'state_hgrn': nrm(ks[6], (L, DEC_BATCH, HG_HEADS, HG_DK, HG_DV), 0.5),
        'state_ffn_conv': nrm(ks[7], (L, DEC_BATCH, CONV_W - 1, D_FF), 1.0),
        'w_ada': nrm(ks[8], (L, D, 6 * D), 0.5 * D ** -0.5),
        'b_ada': nrm(ks[9], (L, 6 * D), 0.01),
        'norm_mix_gain': 1.0 + nrm(ks[10], (L, D), 0.02),
        'w_in': nrm(ks[11], (L, D, IN_WIDTH), D ** -0.5),
        'hg_lb_logits': nrm(ks[12], (L + 1, HG_HEADS * HG_DK), 0.1),
        'hg_norm_gain': 1.0 + nrm(ks[13], (L, HG_DV), 0.02),
        'mla_q_norm_gain': 1.0 + nrm(ks[14], (L, Q_LORA), 0.02),
        'mla_kv_norm_gain': 1.0 + nrm(ks[15], (L, KV_LORA), 0.02),
        'w_uq': nrm(ks[16], (L, Q_LORA, MLA_HEADS * (MLA_NOPE + MLA_ROPE)), Q_LORA ** -0.5),
        'w_uk': nrm(ks[17], (L, KV_LORA, MLA_HEADS, MLA_NOPE), KV_LORA ** -0.5),
        'w_uv': nrm(ks[18], (L, KV_LORA, MLA_HEADS, MLA_V), KV_LORA ** -0.5),
        'w_out': nrm(ks[19], (L, MIX_WIDTH, D), MIX_WIDTH ** -0.5),
        'norm_ffn_gain': 1.0 + nrm(ks[20], (L, D), 0.02),
        'w_up': nrm(ks[21], (L, D, 2 * D_FF), D ** -0.5),
        'conv_w': nrm(ks[22], (L, CONV_W, D_FF), CONV_W ** -0.5),
        'conv_b': nrm(ks[23], (L, D_FF), 0.01),
        'w_down': nrm(ks[24], (L, D_FF, D), D_FF ** -0.5),
        'final_norm_gain': 1.0 + nrm(ks[25], (D,), 0.02),
    }


def reference(x_prompt, x_sample, c_prompt, c_sample, cache_kv_latent, cache_k_rope, state_hgrn,
              state_ffn_conv, w_ada, b_ada, norm_mix_gain, w_in, hg_lb_logits, hg_norm_gain,
              mla_q_norm_gain, mla_kv_norm_gain, w_uq, w_uk, w_uv, w_out, norm_ffn_gain, w_up,
              conv_w, conv_b, w_down, final_norm_gain):
    lower_bounds = jnp.cumsum(jax.nn.softmax(hg_lb_logits.astype(jnp.float32), axis=0), axis=0)
    pos_p = jnp.arange(x_prompt.shape[1])
    pos_s = PAST_LEN + jnp.arange(x_sample.shape[1])
    h_p, h_s = x_prompt, x_sample
    lat_p, kpe_p, hg_p, cv_p = [], [], [], []
    lat_s, kpe_s, hg_s, cv_s = [], [], [], []
    for l in range(DEPTH):
        w = (w_ada[l], b_ada[l], norm_mix_gain[l], w_in[l], lower_bounds[l], hg_norm_gain[l],
             mla_q_norm_gain[l], mla_kv_norm_gain[l], w_uq[l], w_uk[l], w_uv[l], w_out[l],
             norm_ffn_gain[l], w_up[l], conv_w[l], conv_b[l], w_down[l])
        h_p, a, b, cst, d = trunk_layer(h_p, c_prompt, pos_p, w, None, None, None, None)
        lat_p.append(a); kpe_p.append(b); hg_p.append(cst); cv_p.append(d)
        h_s, a, b, cst, d = trunk_layer(h_s, c_sample, pos_s, w, cache_kv_latent[l], cache_k_rope[l],
                                        state_hgrn[l], state_ffn_conv[l])
        lat_s.append(a); kpe_s.append(b); hg_s.append(cst); cv_s.append(d)
    y_prompt = rmsnorm(h_p, final_norm_gain)
    y_sample = rmsnorm(h_s, final_norm_gain)
    return (y_prompt, y_sample,
            jnp.stack(lat_p), jnp.stack(kpe_p), jnp.stack(hg_p), jnp.stack(cv_p),
            jnp.stack(lat_s), jnp.stack(kpe_s), jnp.stack(hg_s), jnp.stack(cv_s))
```

```cpp
#include <hip/hip_runtime.h>
#include <hip/hip_cooperative_groups.h>
#include <stdint.h>
#include <stdio.h>
namespace cg = cooperative_groups;
#ifndef REP_GEMM
#define REP_GEMM 1
#endif
#ifndef REP_ATT
#define REP_ATT 1
#endif
#define REP_WHAT 0
#define REP_P0 1
#define REP_ROW 1
#define REP_P3 1
#define REP_BAR 1
#define REP_TAIL 1

typedef unsigned short bf16_t;
typedef short bf16x8 __attribute__((ext_vector_type(8)));
typedef float f32x4 __attribute__((ext_vector_type(4)));
typedef float f32x2 __attribute__((ext_vector_type(2)));
typedef unsigned u32x4 __attribute__((ext_vector_type(4)));
typedef unsigned u32x2 __attribute__((ext_vector_type(2)));
typedef __bf16 bf16v2 __attribute__((ext_vector_type(2)));

#define DI __device__ __forceinline__
#define MFMA16(a, b, c) __builtin_amdgcn_mfma_f32_16x16x32_bf16((a), (b), (c), 0, 0, 0)

constexpr int TP = 32768, TS = 128, T = TP + TS, TK = T + 32768;
constexpr int NCH = 2048 + 32;
constexpr float EPS = 1e-6f;
constexpr size_t O_Y = 0, O_LATP = 33685504, O_KRP = 42074112, O_HGP = 44171264, O_CVP = 44695552,
                 O_LATS = 44740608, O_KRS = 44773376, O_HGS = 44781568, O_CVS = 45305856;

struct P {
  const float *x_p, *x_s, *c_p, *c_s, *cache_lat, *cache_kpe, *st_hg, *st_conv;
  const float *w_ada, *b_ada, *g_mix, *w_in, *lb_logits, *hg_gain, *qn_g, *kvn_g, *w_uq, *w_uk, *w_uv, *w_out,
      *g_ffn, *w_up, *conv_w, *conv_b, *w_down, *g_final;
  float* out;
  bf16_t *WinT, *WuqT, *WukT, *WuvT, *WoutT, *WupT, *WdownT;
  float *mod, *lb, *rope, *Dbuf;
  bf16_t *hbuf, *hq, *hv, *hgs;
  float* logf;
  bf16_t* mla_raw;
  bf16_t *cqn, *lat_all, *kpe_all, *Q, *Knope, *Vt, *dS, *mix, *abuf, *vbuf, *headA, *headV, *tailA, *sA, *sV, *x1b;
  unsigned* ctr;
};

DI int get_tid() { int t = threadIdx.x; asm volatile("" : "+v"(t)); return t & 255; }
DI unsigned pk2(float lo, float hi) { f32x2 v = {lo, hi}; bf16v2 b = __builtin_convertvector(v, bf16v2); return __builtin_bit_cast(unsigned, b); }
DI bf16_t f2bf(float x) { return (bf16_t)(pk2(x, 0.f) & 0xffffu); }
DI float bf2f(bf16_t x) { return __uint_as_float(((unsigned)x) << 16); }
DI float bflo(unsigned u) { return __uint_as_float(u << 16); }
DI float bfhi(unsigned u) { return __uint_as_float(u & 0xffff0000u); }
DI float wave_sum(float v) {
#pragma unroll
  for (int o = 32; o >= 1; o >>= 1) v += __shfl_xor(v, o);
  return v;
}
DI int row_bidx(int row) { return row < TP ? (row >> 12) : 8 + ((row - TP) >> 4); }
DI int row_pos(int row) { return row < TP ? (row & 4095) : 4096 + ((row - TP) & 15); }
DI int prow32(int r) { const int q = r & 31, i = q & 15; return (r & ~31) + 8 * (i >> 2) + 4 * (q >> 4) + (i & 3); }

#define XB_TMO      128
#define XB_XCNT(j)  (256  + 64 * (j))
#define XB_XSUB(j)  (1280 + 64 * (j))
#define XB_XGEN(j)  (2304 + 64 * (j))
#define XB_TOP      3328
#define XB_TOPGEN   3392
#define XCD_BAR_WORDS 3456
#define XB_SPIN_CAP (1u << 18)
#define CTR_Q 3584
#define LAS __attribute__((address_space(3)))
DI unsigned xb_ld(unsigned* p) { return __hip_atomic_load(p, __ATOMIC_RELAXED, __HIP_MEMORY_SCOPE_AGENT); }
DI unsigned xb_add(unsigned* p, unsigned v) { return __hip_atomic_fetch_add(p, v, __ATOMIC_RELAXED, __HIP_MEMORY_SCOPE_AGENT); }
DI unsigned xb_xcc_id() { return (unsigned)__builtin_amdgcn_s_getreg((3 << 11) | 20) & 0xFu; }
#define XB_SPIN(cond, bar) do { unsigned _sp = 0; while (cond) { __builtin_amdgcn_s_sleep(1); \
    if ((++_sp & 255u) == 0u) { if (xb_ld(&(bar)[XB_TMO])) break; if (_sp > XB_SPIN_CAP) { atomicAdd(&(bar)[XB_TMO], 1u); break; } } } } while (0)
struct XcdBarrier { unsigned* bar; unsigned x; volatile LAS unsigned* st; };
DI XcdBarrier xcd_barrier_post(unsigned* bar, volatile LAS unsigned* st) {
  XcdBarrier b; b.bar = bar; b.x = xb_xcc_id(); b.st = st;
  if (threadIdx.x == 0) st[2] = xb_add(&bar[XB_XCNT(b.x)], 1u);
  return b;
}
DI void xcd_barrier_complete(unsigned* bar, unsigned x, unsigned& nloc, unsigned& nx) {
  const unsigned G = gridDim.x * gridDim.y * gridDim.z;
  unsigned sum, cnt, mine, sp = 0u;
  for (;;) {
    sum = 0u; cnt = 0u; mine = 0u;
#pragma unroll
    for (unsigned j = 0; j < 16; ++j) { const unsigned c = xb_ld(&bar[XB_XCNT(j)]); sum += c; cnt += (c > 0u) ? 1u : 0u; mine = (j == x) ? c : mine; }
    if (sum == G) break;
    __builtin_amdgcn_s_sleep(1);
    if ((++sp & 255u) == 0u) { if (xb_ld(&bar[XB_TMO])) break; if (sp > XB_SPIN_CAP) { atomicAdd(&bar[XB_TMO], 1u); break; } }
  }
  nloc = mine > 0u ? mine : 1u; nx = cnt > 0u ? cnt : 1u;
}
DI void xcd_barrier(const XcdBarrier& b) {
  asm volatile("s_waitcnt vmcnt(0)" ::: "memory");
  __syncthreads();
  if (threadIdx.x == 0) {
    unsigned* bar = b.bar;
    __builtin_amdgcn_s_waitcnt(0);
    unsigned nloc = b.st[0], nx = b.st[1];
    if (nloc == 0u) { xcd_barrier_complete(bar, b.x, nloc, nx); b.st[0] = nloc; b.st[1] = nx; }
    const unsigned old = xb_add(&bar[XB_XSUB(b.x)], 1u);
    const unsigned gen = old / nloc;
    if (old + 1u == (gen + 1u) * nloc) {
      __builtin_amdgcn_fence(__ATOMIC_RELEASE, "agent");
      asm volatile("s_waitcnt vmcnt(0)" ::: "memory");
      const unsigned og = xb_add(&bar[XB_TOP], 1u);
      const unsigned tg = og / nx;
      if (og + 1u == (tg + 1u) * nx) xb_add(&bar[XB_TOPGEN], 1u);
      else XB_SPIN(xb_ld(&bar[XB_TOPGEN]) == tg, bar);
      __builtin_amdgcn_fence(__ATOMIC_ACQUIRE, "agent");
      xb_add(&bar[XB_XGEN(b.x)], 1u);
      asm volatile("s_waitcnt vmcnt(0)" ::: "memory");
    } else {
      XB_SPIN(xb_ld(&bar[XB_XGEN(b.x)]) == gen, bar);
      __builtin_amdgcn_fence(__ATOMIC_ACQUIRE, "agent");
      asm volatile("s_waitcnt vmcnt(0)" ::: "memory");
    }
  }
  __syncthreads();
}
#define gbar(c, t) do { for (int r_ = 0; r_ < REP_BAR; ++r_) xcd_barrier(xb); } while (0)
template <class Epi, bool NOLOAD = false, bool GLU = false, bool PERM = false>
DI void gemm_tile(const bf16_t* __restrict__ A, int lda, const bf16_t* __restrict__ B, int ldb, int K, int m0, int n0,
                  char* lds, const Epi& epi) {
  const int tid = get_tid(), lane = tid & 63, wave = tid >> 6, wr = wave >> 1, wc = wave & 1, fr = lane & 15, fq = lane >> 4;
  f32x4 acc[4][4];
#pragma unroll
  for (int i = 0; i < 4; ++i)
#pragma unroll
    for (int j = 0; j < 4; ++j) acc[i][j] = (f32x4){0.f, 0.f, 0.f, 0.f};
  const int lrow = tid >> 3, lchunk = tid & 7;
  const bf16_t* ga = A + (size_t)(m0 + lrow) * lda + lchunk * 8;
  const bf16_t* gb = B + (size_t)(n0 + (PERM ? prow32(lrow) : lrow)) * ldb + lchunk * 8;
  const int soff = lrow * 128 + ((lchunk ^ (lrow & 7)) << 4);
  u32x4 ra0[4], rb0[4], ra1[4], rb1[4];
  const int nk = K >> 6;
#define G_LOAD(RA, RB, kt) _Pragma("unroll") for (int i = 0; i < 4; ++i) { \
    RA[i] = *(const u32x4*)(ga + (size_t)(32 * i) * lda + (kt) * 64); RB[i] = *(const u32x4*)(gb + (size_t)(32 * i) * ldb + (kt) * 64); }
#define G_STORE(RA, RB, buf) _Pragma("unroll") for (int i = 0; i < 4; ++i) { \
    *(u32x4*)(lds + (buf) * 32768 + soff + i * 4096) = RA[i]; *(u32x4*)(lds + (buf) * 32768 + 16384 + soff + i * 4096) = RB[i]; }
#define G_COMPUTE(buf) _Pragma("unroll") for (int ks = 0; ks < 2; ++ks) { \
    bf16x8 af[4], bfr[4]; const int coff = ((ks * 4 + fq) ^ (fr & 7)) << 4; \
    _Pragma("unroll") for (int i = 0; i < 4; ++i) { \
      af[i] = *(const bf16x8*)(lds + (buf) * 32768 + (wr * 64 + i * 16 + fr) * 128 + coff); \
      bfr[i] = *(const bf16x8*)(lds + (buf) * 32768 + 16384 + (wc * 64 + i * 16 + fr) * 128 + coff); } \
    _Pragma("unroll") for (int mi = 0; mi < 4; ++mi) _Pragma("unroll") for (int ni = 0; ni < 4; ++ni) acc[mi][ni] = MFMA16(bfr[ni], af[mi], acc[mi][ni]); }
#define G_SCHED do { \
    __builtin_amdgcn_sched_group_barrier(0x100, 8, 0); \
    _Pragma("unroll") for (int g_ = 0; g_ < 8; ++g_) { \
      __builtin_amdgcn_sched_group_barrier(0x008, 4, 0); \
      __builtin_amdgcn_sched_group_barrier(0x020, 1, 0); \
      __builtin_amdgcn_sched_group_barrier(0x100, 1, 0); } \
    __builtin_amdgcn_sched_barrier(0); } while (0)
  G_LOAD(ra0, rb0, 0);
  G_LOAD(ra1, rb1, 1);
  G_STORE(ra0, rb0, 0);
  __syncthreads();
  for (int kt = 0; kt < nk; kt += 2) {
    if (!NOLOAD) { const int k2 = (kt + 2 < nk) ? kt + 2 : nk - 1; G_LOAD(ra0, rb0, k2); }
    G_COMPUTE(0);
    G_SCHED;
    G_STORE(ra1, rb1, 1);
    __syncthreads();
    if (!NOLOAD) { const int k3 = (kt + 3 < nk) ? kt + 3 : nk - 1; G_LOAD(ra1, rb1, k3); }
    G_COMPUTE(1);
    G_SCHED;
    G_STORE(ra0, rb0, 0);
    __syncthreads();
  }
#undef G_LOAD
#undef G_SCHED
#undef G_STORE
#undef G_COMPUTE
  if constexpr (PERM) {
#pragma unroll
    for (int mi = 0; mi < 4; ++mi) epi.perm8(m0 + wr * 64 + mi * 16 + fr, n0 + wc * 64 + fq * 8, acc[mi]);
  } else {
#pragma unroll
  for (int mi = 0; mi < 4; ++mi)
#pragma unroll
    for (int ni = 0; ni < 4; ++ni) epi(m0 + wr * 64 + mi * 16 + fr, n0 + wc * 64 + ni * 16 + fq * 4, acc[mi][ni]);
  }
}


DI void fetch_tile(const bf16_t* __restrict__ A, int lda, const bf16_t* __restrict__ B, int ldb, int K, int m0, int n0, unsigned* sink) {
  const int tid = get_tid();
  const int lrow = tid >> 3, lchunk = tid & 7;
  const bf16_t* ga = A + (size_t)(m0 + lrow) * lda + lchunk * 8;
  const bf16_t* gb = B + (size_t)(n0 + lrow) * ldb + lchunk * 8;
  u32x4 x = {0u, 0u, 0u, 0u};
  const int nk = K >> 6;
  for (int kt = 0; kt < nk; ++kt) {
#pragma unroll
    for (int i = 0; i < 4; ++i) {
      x |= *(const u32x4*)(ga + (size_t)(32 * i) * lda + kt * 64);
      x |= *(const u32x4*)(gb + (size_t)(32 * i) * ldb + kt * 64);
    }
  }
  if ((x[0] | x[1] | x[2] | x[3]) == 0x12345u) *sink = 1u;
}
DI int swz4(int row) { return (4 - ((row >> 2) & 3)) & 3; }
template <class Epi, bool GLU = false, bool GROUP = false>
DI void gemm256(const bf16_t* __restrict__ A, int lda, const bf16_t* __restrict__ B, int ldb, int K, int m0, int n0, int mlimit,
                char* lds, const Epi& epi) {
  const int tid = get_tid(), lane = tid & 63, wave = tid >> 6, wr = wave >> 1, wc = wave & 1, fr = lane & 15, fq = lane >> 4;
  f32x4 acc[8][4];
#pragma unroll
  for (int i = 0; i < 8; ++i)
#pragma unroll
    for (int j = 0; j < 4; ++j) acc[i][j] = (f32x4){0.f, 0.f, 0.f, 0.f};
  const int lrow = tid >> 2, lchunk = tid & 3;
  const bf16_t* ga = A + (size_t)(m0 + lrow) * lda + lchunk * 8;
  const bf16_t* gb = B + (size_t)(n0 + lrow) * ldb + lchunk * 8;
  const int soff = lrow * 64 + ((lchunk ^ swz4(lrow)) << 4);
  const int coff = (fq ^ swz4(fr)) << 4;
  u32x4 ra0[4], rb0[2], ra1[4], rb1[2];
  const int nk = K >> 5;
#define H_LOAD(RA, RB, kt) { _Pragma("unroll") for (int i = 0; i < 4; ++i) RA[i] = *(const u32x4*)(ga + (size_t)(64 * i) * lda + (kt) * 32); \
    _Pragma("unroll") for (int i = 0; i < 2; ++i) RB[i] = *(const u32x4*)(gb + (size_t)(64 * i) * ldb + (kt) * 32); }
#define H_STORE(RA, RB, buf) { _Pragma("unroll") for (int i = 0; i < 4; ++i) *(u32x4*)(lds + (buf) * 24576 + soff + i * 4096) = RA[i]; \
    _Pragma("unroll") for (int i = 0; i < 2; ++i) *(u32x4*)(lds + (buf) * 24576 + 16384 + soff + i * 4096) = RB[i]; }
#define H_COMPUTE(buf) { bf16x8 bfr[4]; \
    _Pragma("unroll") for (int i = 0; i < 4; ++i) bfr[i] = *(const bf16x8*)(lds + (buf) * 24576 + 16384 + (wc * 64 + i * 16 + fr) * 64 + coff); \
    _Pragma("unroll") for (int hh = 0; hh < 2; ++hh) { bf16x8 af[4]; \
      _Pragma("unroll") for (int i = 0; i < 4; ++i) af[i] = *(const bf16x8*)(lds + (buf) * 24576 + (wr * 128 + (hh * 4 + i) * 16 + fr) * 64 + coff); \
      _Pragma("unroll") for (int mi = 0; mi < 4; ++mi) _Pragma("unroll") for (int ni = 0; ni < 4; ++ni) acc[hh * 4 + mi][ni] = MFMA16(bfr[ni], af[mi], acc[hh * 4 + mi][ni]); } }
#define H_SCHED do { \
    __builtin_amdgcn_sched_group_barrier(0x100, 8, 0); \
    _Pragma("unroll") for (int g_ = 0; g_ < 4; ++g_) { \
      __builtin_amdgcn_sched_group_barrier(0x008, 4, 0); \
      __builtin_amdgcn_sched_group_barrier(0x020, 1, 0); \
      __builtin_amdgcn_sched_group_barrier(0x100, 1, 0); } \
    _Pragma("unroll") for (int g_ = 0; g_ < 2; ++g_) { \
      __builtin_amdgcn_sched_group_barrier(0x008, 4, 0); \
      __builtin_amdgcn_sched_group_barrier(0x020, 1, 0); } \
    __builtin_amdgcn_sched_group_barrier(0x008, 8, 0); \
    __builtin_amdgcn_sched_barrier(0); } while (0)
  H_LOAD(ra0, rb0, 0);
  H_LOAD(ra1, rb1, 1);
  H_STORE(ra0, rb0, 0);
  __syncthreads();
#pragma unroll 1
  for (int kt = 0; kt < nk; kt += 2) {
    { const int k2 = (kt + 2 < nk) ? kt + 2 : nk - 1; H_LOAD(ra0, rb0, k2); }
    H_COMPUTE(0);
    H_SCHED;
    H_STORE(ra1, rb1, 1);
    __syncthreads();
    { const int k3 = (kt + 3 < nk) ? kt + 3 : nk - 1; H_LOAD(ra1, rb1, k3); }
    H_COMPUTE(1);
    H_SCHED;
    H_STORE(ra0, rb0, 0);
    __syncthreads();
  }
#undef H_LOAD
#undef H_STORE
#undef H_COMPUTE
#undef H_SCHED
  if constexpr (GLU) { epi.glu(acc, m0 + wr * 128, (n0 >> 6) + wc, fr, fq); }
  else {
#pragma unroll
    for (int mi = 0; mi < 8; ++mi) {
      const int row = m0 + wr * 128 + mi * 16 + fr;
      if (row < mlimit) {
        if constexpr (GROUP) epi.group4(row, n0 + wc * 64 + fq * 4, acc[mi]);
        else {
#pragma unroll
          for (int ni = 0; ni < 4; ++ni) epi(row, n0 + wc * 64 + ni * 16 + fq * 4, acc[mi][ni]);
        }
      }
    }
  }
}

DI bool tile_next(int k, int MTt, int NTt, int& mt, int& nt, int slot = -1) {
  const int G = gridDim.x, b = blockIdx.x, per = G >> 3;
  const int L = k * G + (slot >= 0 ? slot : (b & 7) * per + (b >> 3));
  if (L >= MTt * NTt) return false;
  const int nig = 8 * NTt, gid = L / nig, fm = gid * 8, rem = MTt - fm, gsz = rem < 8 ? rem : 8, w = L - gid * nig;
  mt = fm + (w % gsz); nt = w / gsz;
  return true;
}
template <class Epi, bool GLU = false, bool GROUP = false, bool PERM = false>
DI void gemm256_stream(const bf16_t* __restrict__ A, int lda, const bf16_t* __restrict__ B, int ldb, int K, int MTt, int NTt, int mlimit,
                       char* lds, const Epi& epi, int slot = -1) {
  const int tid = get_tid(), lane = tid & 63, wave = tid >> 6, wr = wave >> 1, wc = wave & 1, fr = lane & 15, fq = lane >> 4;
  int mt, nt;
  if (!tile_next(0, MTt, NTt, mt, nt, slot)) return;
  const int lrow = tid >> 2, lchunk = tid & 3;
  const bf16_t* ga = A + (size_t)(mt * 256 + lrow) * lda + lchunk * 8;
  const int brow = PERM ? prow32(lrow) : lrow;
  const bf16_t* gb = B + (size_t)(nt * 128 + brow) * ldb + lchunk * 8;
  const int soff = lrow * 64 + ((lchunk ^ swz4(lrow)) << 4);
  const int coff = (fq ^ swz4(fr)) << 4;
  u32x4 ra0[4], rb0[2], ra1[4], rb1[2];
  const int nk = K >> 5;
#define H_LOADP(RA, RB, PA, PB, kt) { _Pragma("unroll") for (int i = 0; i < 4; ++i) RA[i] = *(const u32x4*)((PA) + (size_t)(64 * i) * lda + (kt) * 32); \
    _Pragma("unroll") for (int i = 0; i < 2; ++i) RB[i] = *(const u32x4*)((PB) + (size_t)(64 * i) * ldb + (kt) * 32); }
#define H_STORE(RA, RB, buf) { _Pragma("unroll") for (int i = 0; i < 4; ++i) *(u32x4*)(lds + (buf) * 24576 + soff + i * 4096) = RA[i]; \
    _Pragma("unroll") for (int i = 0; i < 2; ++i) *(u32x4*)(lds + (buf) * 24576 + 16384 + soff + i * 4096) = RB[i]; }
#define H_COMPUTE(buf) { bf16x8 bfr[4]; \
    _Pragma("unroll") for (int i = 0; i < 4; ++i) bfr[i] = *(const bf16x8*)(lds + (buf) * 24576 + 16384 + (wc * 64 + i * 16 + fr) * 64 + coff); \
    _Pragma("unroll") for (int hh = 0; hh < 2; ++hh) { bf16x8 af[4]; \
      _Pragma("unroll") for (int i = 0; i < 4; ++i) af[i] = *(const bf16x8*)(lds + (buf) * 24576 + (wr * 128 + (hh * 4 + i) * 16 + fr) * 64 + coff); \
      _Pragma("unroll") for (int mi = 0; mi < 4; ++mi) _Pragma("unroll") for (int ni = 0; ni < 4; ++ni) acc[hh * 4 + mi][ni] = MFMA16(bfr[ni], af[mi], acc[hh * 4 + mi][ni]); } }
#define H_SCHED do { \
    __builtin_amdgcn_sched_group_barrier(0x100, 8, 0); \
    _Pragma("unroll") for (int g_ = 0; g_ < 4; ++g_) { \
      __builtin_amdgcn_sched_group_barrier(0x008, 4, 0); \
      __builtin_amdgcn_sched_group_barrier(0x020, 1, 0); \
      __builtin_amdgcn_sched_group_barrier(0x100, 1, 0); } \
    _Pragma("unroll") for (int g_ = 0; g_ < 2; ++g_) { \
      __builtin_amdgcn_sched_group_barrier(0x008, 4, 0); \
      __builtin_amdgcn_sched_group_barrier(0x020, 1, 0); } \
    __builtin_amdgcn_sched_group_barrier(0x008, 8, 0); \
    __builtin_amdgcn_sched_barrier(0); } while (0)
  H_LOADP(ra0, rb0, ga, gb, 0);
  H_LOADP(ra1, rb1, ga, gb, 1);
  H_STORE(ra0, rb0, 0);
  __syncthreads();
#pragma unroll 1
  for (int k = 0;; ++k) {
    int nmt, nnt;
    const bool has_next = tile_next(k + 1, MTt, NTt, nmt, nnt, slot);
    const bf16_t* nga = has_next ? A + (size_t)(nmt * 256 + lrow) * lda + lchunk * 8 : ga;
    const bf16_t* ngb = has_next ? B + (size_t)(nnt * 128 + brow) * ldb + lchunk * 8 : gb;
    f32x4 acc[8][4];
#pragma unroll
    for (int i = 0; i < 8; ++i)
#pragma unroll
      for (int j = 0; j < 4; ++j) acc[i][j] = (f32x4){0.f, 0.f, 0.f, 0.f};
#pragma unroll 1
    for (int kt = 0; kt < nk; kt += 2) {
      { const bool cur = kt + 2 < nk; const bf16_t* pa = cur ? ga : nga; const bf16_t* pb = cur ? gb : ngb; const int kk = cur ? kt + 2 : 0; H_LOADP(ra0, rb0, pa, pb, kk); }
      H_COMPUTE(0);
      H_SCHED;
      H_STORE(ra1, rb1, 1);
      __syncthreads();
      { const bool cur = kt + 3 < nk; const bf16_t* pa = cur ? ga : nga; const bf16_t* pb = cur ? gb : ngb; const int kk = cur ? kt + 3 : 1; H_LOADP(ra1, rb1, pa, pb, kk); }
      H_COMPUTE(1);
      H_SCHED;
      H_STORE(ra0, rb0, 0);
      __syncthreads();
    }
    const int m0 = mt * 256, n0 = nt * 128;
    if constexpr (GLU) { if constexpr (PERM) epi.glu_perm(acc, m0 + wr * 128, (n0 >> 6) + wc, fr, fq); else epi.glu(acc, m0 + wr * 128, (n0 >> 6) + wc, fr, fq); }
    else {
#pragma unroll
      for (int mi = 0; mi < 8; ++mi) {
        const int row = m0 + wr * 128 + mi * 16 + fr;
        if (row < mlimit) {
          if constexpr (PERM) epi.perm8(row, n0 + wc * 64 + fq * 8, acc[mi]);
          else if constexpr (GROUP) epi.group4(row, n0 + wc * 64 + fq * 4, acc[mi]);
          else {
#pragma unroll
            for (int ni = 0; ni < 4; ++ni) epi(row, n0 + wc * 64 + ni * 16 + fq * 4, acc[mi][ni]);
          }
        }
      }
    }
    if (!has_next) break;
    mt = nmt; nt = nnt; ga = nga; gb = ngb;
  }
#undef H_LOADP
#undef H_STORE
#undef H_COMPUTE
#undef H_SCHED
}

DI void st_bf8(bf16_t* dst, f32x4 lo, f32x4 hi) { u32x4 w = {pk2(lo[0], lo[1]), pk2(lo[2], lo[3]), pk2(hi[0], hi[1]), pk2(hi[2], hi[3])}; *(u32x4*)dst = w; }
DI void st_bf4(bf16_t* dst, f32x4 v) { u32x2 w = {pk2(v[0], v[1]), pk2(v[2], v[3])}; *(u32x2*)dst = w; }

struct EpiProj {
  P p;
  DI void operator()(int row, int col, f32x4 v) const {
    if (col < 512) {
      st_bf4(p.hq + (size_t)row * 512 + col, v);
    } else if (col < 1024) {
      const int c = col - 512;
      f32x4 lbv = *(const f32x4*)(p.lb + c), o;
#pragma unroll
      for (int j = 0; j < 4; ++j) { float sg = 1.f / (1.f + __expf(-v[j])); o[j] = logf(lbv[j] + (1.f - lbv[j]) * sg); }
      *(f32x4*)(p.logf + (size_t)row * 512 + c) = o;
    } else if (col < 1536) {
      st_bf4(p.hv + (size_t)row * 512 + (col - 1024), v);
    } else if (col < 2048) {
      f32x4 o;
#pragma unroll
      for (int j = 0; j < 4; ++j) o[j] = v[j] / (1.f + __expf(-v[j]));
      st_bf4(p.hgs + (size_t)row * 512 + (col - 1536), o);
    } else if (col < 2752) {
      st_bf4(p.mla_raw + (size_t)row * 704 + (col - 2048), v);
    }
  }
  DI void perm8(int row, int cb, const f32x4 (&v)[4]) const {
    if (cb < 512) {
#pragma unroll
      for (int q = 0; q < 2; ++q) st_bf8(p.hq + (size_t)row * 512 + cb + q * 32, v[2 * q], v[2 * q + 1]);
    } else if (cb < 1024) {
      const int c = cb - 512;
      f32x4 lbv[4], o[4];
#pragma unroll
      for (int q = 0; q < 2; ++q) { lbv[2 * q] = *(const f32x4*)(p.lb + c + q * 32); lbv[2 * q + 1] = *(const f32x4*)(p.lb + c + q * 32 + 4); }
#pragma unroll
      for (int ni = 0; ni < 4; ++ni)
#pragma unroll
        for (int j = 0; j < 4; ++j) { float sg = 1.f / (1.f + __expf(-v[ni][j])); o[ni][j] = __logf(lbv[ni][j] + (1.f - lbv[ni][j]) * sg); }
#pragma unroll
      for (int q = 0; q < 2; ++q) { float* d = p.logf + (size_t)row * 512 + c + q * 32; *(f32x4*)d = o[2 * q]; *(f32x4*)(d + 4) = o[2 * q + 1]; }
    } else if (cb < 1536) {
#pragma unroll
      for (int q = 0; q < 2; ++q) st_bf8(p.hv + (size_t)row * 512 + (cb - 1024) + q * 32, v[2 * q], v[2 * q + 1]);
    } else if (cb < 2048) {
      f32x4 o[4];
#pragma unroll
      for (int ni = 0; ni < 4; ++ni)
#pragma unroll
        for (int j = 0; j < 4; ++j) o[ni][j] = v[ni][j] / (1.f + __expf(-v[ni][j]));
#pragma unroll
      for (int q = 0; q < 2; ++q) st_bf8(p.hgs + (size_t)row * 512 + (cb - 1536) + q * 32, o[2 * q], o[2 * q + 1]);
    } else if (cb < 2752) {
#pragma unroll
      for (int q = 0; q < 2; ++q) st_bf8(p.mla_raw + (size_t)row * 704 + (cb - 2048) + q * 32, v[2 * q], v[2 * q + 1]);
    }
  }
  DI void group4(int row, int col, const f32x4 (&v)[4]) const {
    if (col >= 512 && col < 1024) {
      const int c = col - 512;
      f32x4 lbv[4], o[4];
#pragma unroll
      for (int ni = 0; ni < 4; ++ni) lbv[ni] = *(const f32x4*)(p.lb + c + ni * 16);
#pragma unroll
      for (int ni = 0; ni < 4; ++ni)
#pragma unroll
        for (int j = 0; j < 4; ++j) { float sg = 1.f / (1.f + __expf(-v[ni][j])); o[ni][j] = logf(lbv[ni][j] + (1.f - lbv[ni][j]) * sg); }
#pragma unroll
      for (int ni = 0; ni < 4; ++ni) *(f32x4*)(p.logf + (size_t)row * 512 + c + ni * 16) = o[ni];
    } else {
#pragma unroll
      for (int ni = 0; ni < 4; ++ni) (*this)(row, col + ni * 16, v[ni]);
    }
  }
};
constexpr float QSCALE = 0.07216878364870322f * 1.4426950408889634f;
struct EpiQ {
  P p;
  DI void operator()(int row, int col, f32x4 v) const {
    if (col < 512) {
      const int h = col >> 7, d = col & 127;
      st_bf4(p.Q + (size_t)row * 768 + h * 192 + d, v * QSCALE);
    } else {
      const int c = col - 512, h = c >> 6, i = (c & 63) >> 1;
      const float* cs = p.rope + ((size_t)row_pos(row) * 32 + i) * 2;
      f32x4 t = *(const f32x4*)cs, o;
      o[0] = v[0] * t[0] - v[1] * t[1]; o[1] = v[1] * t[0] + v[0] * t[1];
      o[2] = v[2] * t[2] - v[3] * t[3]; o[3] = v[3] * t[2] + v[2] * t[3];
      st_bf4(p.Q + (size_t)row * 768 + h * 192 + 128 + (c & 63), o * QSCALE);
    }
  }
  DI void perm8(int row, int cb, const f32x4 (&v)[4]) const {
    if (cb < 512) {
      const int h = cb >> 7, d = cb & 127;
#pragma unroll
      for (int q = 0; q < 2; ++q) st_bf8(p.Q + (size_t)row * 768 + h * 192 + d + q * 32, v[2 * q] * QSCALE, v[2 * q + 1] * QSCALE);
    } else {
      const int c = cb - 512, h = c >> 6, w = c & 63;
      const float* cs = p.rope + ((size_t)row_pos(row) * 32 + (w >> 1)) * 2;
      f32x4 t[4];
#pragma unroll
      for (int q = 0; q < 2; ++q) { t[2 * q] = *(const f32x4*)(cs + q * 32); t[2 * q + 1] = *(const f32x4*)(cs + q * 32 + 4); }
#pragma unroll
      for (int q = 0; q < 2; ++q) {
        f32x4 o[2];
#pragma unroll
        for (int u = 0; u < 2; ++u) {
          const f32x4 x = v[2 * q + u], tt = t[2 * q + u];
          o[u][0] = x[0] * tt[0] - x[1] * tt[1]; o[u][1] = x[1] * tt[0] + x[0] * tt[1];
          o[u][2] = x[2] * tt[2] - x[3] * tt[3]; o[u][3] = x[3] * tt[2] + x[2] * tt[3];
        }
        st_bf8(p.Q + (size_t)row * 768 + h * 192 + 128 + w + q * 32, o[0] * QSCALE, o[1] * QSCALE);
      }
    }
  }
};
struct EpiDry { P p; bool on; DI void operator()(int row, int col, f32x4 v) const { if (on) st_bf4(p.abuf + (size_t)row * 2816 + (col % 2816), v); } };
struct EpiKn { P p; DI void operator()(int row, int col, f32x4 v) const { st_bf4(p.Knope + (size_t)row * 512 + col, v); }
  DI void perm8(int row, int cb, const f32x4 (&v)[4]) const {
#pragma unroll
    for (int q = 0; q < 2; ++q) st_bf8(p.Knope + (size_t)row * 512 + cb + q * 32, v[2 * q], v[2 * q + 1]); } };
struct EpiVt { P p; DI void operator()(int row, int col, f32x4 v) const { st_bf4(p.Vt + (size_t)row * TK + col, v); }
  DI void perm8(int row, int cb, const f32x4 (&v)[4]) const {
#pragma unroll
    for (int q = 0; q < 2; ++q) st_bf8(p.Vt + (size_t)row * TK + cb + q * 32, v[2 * q], v[2 * q + 1]); } };
struct EpiOut {
  P p;
  DI void operator()(int row, int col, f32x4 v) const {
    const float* xr = row < TP ? p.x_p + (size_t)row * 1024 : p.x_s + (size_t)(row - TP) * 1024;
    f32x4 x = *(const f32x4*)(xr + col), g = *(const f32x4*)(p.mod + row_bidx(row) * 6144 + 2048 + col);
    st_bf4(p.x1b + (size_t)row * 1024 + col, x + g * v);
  }
  DI void perm8(int row, int cb, const f32x4 (&v)[4]) const {
    const float* xr = (row < TP ? p.x_p + (size_t)row * 1024 : p.x_s + (size_t)(row - TP) * 1024) + cb;
    const float* gr = p.mod + row_bidx(row) * 6144 + 2048 + cb;
    f32x4 x[4], g[4];
#pragma unroll
    for (int q = 0; q < 2; ++q) { x[2 * q] = *(const f32x4*)(xr + q * 32); x[2 * q + 1] = *(const f32x4*)(xr + q * 32 + 4); g[2 * q] = *(const f32x4*)(gr + q * 32); g[2 * q + 1] = *(const f32x4*)(gr + q * 32 + 4); }
#pragma unroll
    for (int q = 0; q < 2; ++q) st_bf8(p.x1b + (size_t)row * 1024 + cb + q * 32, x[2 * q] + g[2 * q] * v[2 * q], x[2 * q + 1] + g[2 * q + 1] * v[2 * q + 1]);
  }
};
DI float gelu_erf(float v) {
  const float av = fabsf(v), t = __builtin_amdgcn_rcpf(av * 0.2316418882f + 1.0f);
  float q = t * 0.5307027145f + (-0.7265760135f); q = q * t + 0.7107068705f; q = q * t + (-0.142248368f); q = q * t + 0.127414796f; q = q * t;
  const float e = __builtin_amdgcn_exp2f(v * v * (-0.72134752044f));
  const float m = v * (q * e);
  return v < 0.f ? m : v - m;
}
DI float dpp_ror1(float x) { return __int_as_float(__builtin_amdgcn_update_dpp(0, __float_as_int(x), 0x121, 0xf, 0xf, false)); }
DI float dpp_ror2(float x) { return __int_as_float(__builtin_amdgcn_update_dpp(0, __float_as_int(x), 0x122, 0xf, 0xf, false)); }
struct EpiGlu {
  P p;
  DI void glu_perm(const f32x4 (&acc)[8][4], int rbase, int blk32, int fr, int fq) const {
    if (rbase >= T) return;
    const bool sample = rbase >= TP;
    const int f0 = blk32 * 32 + fq * 8;
    f32x4 w0[2], w1[2], w2[2], cb[2];
#pragma unroll
    for (int ni = 0; ni < 2; ++ni) {
      w0[ni] = *(const f32x4*)(p.conv_w + f0 + ni * 4); w1[ni] = *(const f32x4*)(p.conv_w + 2816 + f0 + ni * 4);
      w2[ni] = *(const f32x4*)(p.conv_w + 5632 + f0 + ni * 4); cb[ni] = *(const f32x4*)(p.conv_b + f0 + ni * 4);
    }
#pragma unroll
    for (int mi = 0; mi < 8; ++mi) {
      const int row = rbase + mi * 16 + fr;
      f32x4 g[2];
#pragma unroll
      for (int ni = 0; ni < 2; ++ni)
#pragma unroll
        for (int j = 0; j < 4; ++j) {
          const float a = acc[mi][ni][j];
          const float s1 = dpp_ror1(a), s2 = dpp_ror2(a);
          const float q1 = ((mi & 3) > 0) ? dpp_ror1(acc[mi > 0 ? mi - 1 : 0][ni][j]) : 0.f, q2 = ((mi & 3) > 0) ? dpp_ror2(acc[mi > 0 ? mi - 1 : 0][ni][j]) : 0.f;
          const float a1 = fr >= 1 ? s1 : q1, a2 = fr >= 2 ? s2 : q2;
          const float cv = cb[ni][j] + w0[ni][j] * a2 + w1[ni][j] * a1 + w2[ni][j] * a;
          g[ni][j] = gelu_erf(cv) * acc[mi][ni + 2][j];
        }
      if (sample) {
        st_bf8(p.sA + (size_t)(row - TP) * 2816 + f0, acc[mi][0], acc[mi][1]);
        st_bf8(p.sV + (size_t)(row - TP) * 2816 + f0, acc[mi][2], acc[mi][3]);
        const int pos = (row - TP) & 15;
        if (pos >= 14) { float* d = p.out + O_CVS + ((size_t)((row - TP) >> 4) * 2 + (pos - 14)) * 2816 + f0; *(f32x4*)d = acc[mi][0]; *(f32x4*)(d + 4) = acc[mi][1]; }
      } else {
        const int i64 = (mi & 3) * 16 + fr;
        if (i64 < 2) {
          st_bf8(p.headA + ((size_t)(row >> 6) * 2 + i64) * 2816 + f0, acc[mi][0], acc[mi][1]);
          st_bf8(p.headV + ((size_t)(row >> 6) * 2 + i64) * 2816 + f0, acc[mi][2], acc[mi][3]);
        } else {
          st_bf8(p.vbuf + (size_t)row * 2816 + f0, g[0], g[1]);
          if (i64 >= 62) {
            st_bf8(p.tailA + ((size_t)(row >> 6) * 2 + (i64 - 62)) * 2816 + f0, acc[mi][0], acc[mi][1]);
            const int pos = row & 4095;
            if (pos >= 4094) { float* d = p.out + O_CVP + ((size_t)(row >> 12) * 2 + (pos - 4094)) * 2816 + f0; *(f32x4*)d = acc[mi][0]; *(f32x4*)(d + 4) = acc[mi][1]; }
          }
        }
      }
    }
  }
  DI void glu(const f32x4 (&acc)[8][4], int rbase, int blk32, int fr, int fq) const {
    if (rbase >= T) return;
    const bool sample = rbase >= TP;
#pragma unroll
    for (int ni = 0; ni < 2; ++ni) {
      const int f = blk32 * 32 + ni * 16 + fq * 4;
      const f32x4 w0 = *(const f32x4*)(p.conv_w + f), w1 = *(const f32x4*)(p.conv_w + 2816 + f), w2 = *(const f32x4*)(p.conv_w + 5632 + f), cb = *(const f32x4*)(p.conv_b + f);
#pragma unroll
      for (int mi = 0; mi < 8; ++mi) {
        const int row = rbase + mi * 16 + fr;
        const f32x4 a = acc[mi][ni], v = acc[mi][ni + 2];
        f32x4 g;
#pragma unroll
        for (int j = 0; j < 4; ++j) {
          const float s1 = dpp_ror1(a[j]), s2 = dpp_ror2(a[j]);
          const float q1 = ((mi & 3) > 0) ? dpp_ror1(acc[mi > 0 ? mi - 1 : 0][ni][j]) : 0.f, q2 = ((mi & 3) > 0) ? dpp_ror2(acc[mi > 0 ? mi - 1 : 0][ni][j]) : 0.f;
          const float a1 = fr >= 1 ? s1 : q1, a2 = fr >= 2 ? s2 : q2;
          const float cv = cb[j] + w0[j] * a2 + w1[j] * a1 + w2[j] * a[j];
          g[j] = gelu_erf(cv) * v[j];
        }
        if (sample) {
          st_bf4(p.sA + (size_t)(row - TP) * 2816 + f, a);
          st_bf4(p.sV + (size_t)(row - TP) * 2816 + f, v);
          const int pos = (row - TP) & 15;
          if (pos >= 14) *(f32x4*)(p.out + O_CVS + ((size_t)((row - TP) >> 4) * 2 + (pos - 14)) * 2816 + f) = a;
        } else {
          const int i64 = (mi & 3) * 16 + fr;
          if (i64 < 2) {
            st_bf4(p.headA + ((size_t)(row >> 6) * 2 + i64) * 2816 + f, a);
            st_bf4(p.headV + ((size_t)(row >> 6) * 2 + i64) * 2816 + f, v);
          } else {
            st_bf4(p.vbuf + (size_t)row * 2816 + f, g);
            if (i64 >= 62) {
              st_bf4(p.tailA + ((size_t)(row >> 6) * 2 + (i64 - 62)) * 2816 + f, a);
              const int pos = row & 4095;
              if (pos >= 4094) *(f32x4*)(p.out + O_CVP + ((size_t)(row >> 12) * 2 + (pos - 4094)) * 2816 + f) = a;
            }
          }
        }
      }
    }
  }
};
struct EpiDown {
  P p; bool dry;
  DI void operator()(int row, int col, f32x4 v) const {
    const u32x2 xb = *(const u32x2*)(p.x1b + (size_t)row * 1024 + col);
    const f32x4 x = {bflo(xb[0]), bfhi(xb[0]), bflo(xb[1]), bfhi(xb[1])}, g = *(const f32x4*)(p.mod + row_bidx(row) * 6144 + 5120 + col);
    if (!dry) st_bf4(p.hbuf + (size_t)row * 1024 + col, x + g * v);
  }
  DI void perm8(int row, int cb, const f32x4 (&v)[4]) const {
    const float* gr = p.mod + row_bidx(row) * 6144 + 5120 + cb;
    u32x4 xb[2]; f32x4 g[4];
#pragma unroll
    for (int q = 0; q < 2; ++q) { xb[q] = *(const u32x4*)(p.x1b + (size_t)row * 1024 + cb + q * 32); g[2 * q] = *(const f32x4*)(gr + q * 32); g[2 * q + 1] = *(const f32x4*)(gr + q * 32 + 4); }
#pragma unroll
    for (int q = 0; q < 2; ++q) {
      const f32x4 xlo = {bflo(xb[q][0]), bfhi(xb[q][0]), bflo(xb[q][1]), bfhi(xb[q][1])}, xhi = {bflo(xb[q][2]), bfhi(xb[q][2]), bflo(xb[q][3]), bfhi(xb[q][3])};
      if (!dry) st_bf8(p.hbuf + (size_t)row * 1024 + cb + q * 32, xlo + g[2 * q] * v[2 * q], xhi + g[2 * q + 1] * v[2 * q + 1]);
    }
  }
};

DI int uq_dest(int n) { const int h = n / 192, d = n - h * 192; if (d < 128) return h * 128 + d; const int r = d - 128; return 512 + h * 64 + 2 * (r & 31) + (r >> 5); }
DI int up_dest(int n) { return n < 2816 ? (n >> 5) * 64 + (n & 31) : ((n - 2816) >> 5) * 64 + 32 + ((n - 2816) & 31); }
DI void transpose_tile(const float* __restrict__ W, int K, int N, bf16_t* __restrict__ Wt, int k0, int n0, int mode, char* lds) {
  float* s = (float*)lds;
  const int tid = get_tid();
  __syncthreads();
#pragma unroll
  for (int r = 0; r < 16; ++r) {
    const int i = (tid >> 6) + 4 * r, j = tid & 63, n = n0 + j;
    s[i * 65 + j] = (n < N) ? W[(size_t)(k0 + i) * N + n] : 0.f;
  }
  __syncthreads();
#pragma unroll
  for (int r = 0; r < 16; ++r) {
    const int i = tid & 63, j = (tid >> 6) + 4 * r, n = n0 + j;
    const int dn = (mode == 1) ? uq_dest(n) : (mode == 2) ? up_dest(n) : n;
    Wt[(size_t)dn * K + k0 + i] = f2bf(s[i * 65 + j]);
  }
}
DI void mod_item(const P& p, int item, char* lds) {
  float* sc = (float*)lds;
  const int tid = get_tid();
  __syncthreads();
  for (int e = tid; e < 16384; e += 256) {
    const int r = e >> 10, k = e & 1023;
    const float c = (r < 8) ? p.c_p[r * 1024 + k] : p.c_s[(r - 8) * 1024 + k];
    sc[e] = c / (1.f + __expf(-c));
  }
  __syncthreads();
  const int col = item * 32 + (tid & 31), kg = tid >> 5;
  float acc[16];
#pragma unroll
  for (int r = 0; r < 16; ++r) acc[r] = 0.f;
  for (int k0 = kg * 128; k0 < kg * 128 + 128; k0 += 16) {
    float w[16];
#pragma unroll
    for (int u = 0; u < 16; ++u) w[u] = p.w_ada[(size_t)(k0 + u) * 6144 + col];
#pragma unroll
    for (int u = 0; u < 16; ++u)
#pragma unroll
      for (int r = 0; r < 16; ++r) acc[r] += sc[r * 1024 + k0 + u] * w[u];
  }
  __syncthreads();
#pragma unroll
  for (int r = 0; r < 16; ++r) sc[(kg * 16 + r) * 32 + (tid & 31)] = acc[r];
  __syncthreads();
  for (int e = tid; e < 512; e += 256) {
    const int r = e >> 5, c = e & 31;
    float s = p.b_ada[item * 32 + c];
#pragma unroll
    for (int g = 0; g < 8; ++g) s += sc[(g * 16 + r) * 32 + c];
    p.mod[r * 6144 + item * 32 + c] = s;
  }
}
DI void rope_item(const P& p, int item) {
  const int e = item * 256 + get_tid();
  if (e >= 4112 * 32) return;
  const int pos = e >> 5, i = e & 31;
  double f = 1.0;
  for (int q = 0; q < i; ++q) f *= 0.7498942093324559;
  double ang = (double)pos * f;
  const double TWO_PI = 6.283185307179586476925;
  double n = __builtin_rint(ang / TWO_PI);
  double r = ang - n * TWO_PI;
  double r2 = r * r;
  double s = 0.0, c = 0.0;
  double ts = r, tc = 1.0;
  s = ts; c = tc;
#pragma unroll 1
  for (int q = 1; q <= 14; ++q) {
    tc = -tc * r2 / (double)((2 * q - 1) * (2 * q));
    ts = -ts * r2 / (double)((2 * q) * (2 * q + 1));
    c += tc; s += ts;
  }
  p.rope[(size_t)e * 2] = (float)c;
  p.rope[(size_t)e * 2 + 1] = (float)s;
}
DI void cache_item(const P& p, int item) {
  const int tid = get_tid();
  const size_t r0 = (size_t)item * 64;
  f32x4 v[16]; float k0[8], k1[8];
#pragma unroll
  for (int i = 0; i < 16; ++i) v[i] = *(const f32x4*)(p.cache_lat + r0 * 256 + (size_t)(tid + 256 * i) * 4);
#pragma unroll
  for (int i = 0; i < 8; ++i) {
    const int e = tid + 256 * i, row = e >> 5, q = e & 31;
    const float* src = p.cache_kpe + (r0 + row) * 64;
    k0[i] = src[q]; k1[i] = src[32 + q];
  }
#pragma unroll
  for (int i = 0; i < 16; ++i) st_bf4(p.lat_all + ((size_t)T + r0) * 256 + (size_t)(tid + 256 * i) * 4, v[i]);
#pragma unroll
  for (int i = 0; i < 8; ++i) {
    const int e = tid + 256 * i, row = e >> 5, q = e & 31;
    *(unsigned*)(p.kpe_all + ((size_t)T + r0 + row) * 64 + 2 * q) = pk2(k0[i], k1[i]);
  }
}
constexpr int NT_IN = 16 * 44, NT_UQ = 6 * 12, NT_UK = 4 * 8, NT_OUT = 16 * 16, NT_UP = 16 * 88, NT_DN = 44 * 16;
constexpr int P0_TR = NT_IN + NT_UQ + 2 * NT_UK + NT_OUT + NT_UP + NT_DN;
constexpr int P0_MOD = 192, P0_ROPE = 514, P0_CACHE = 512;
constexpr int P0_TOTAL = P0_TR + P0_MOD + P0_ROPE + P0_CACHE + 1, P0_EARLY = P0_MOD + NT_IN;
DI void p0_item(const P& p, int it, char* lds) {
  {
    int i = it;
    if (i < P0_MOD) { mod_item(p, i, lds); return; }
    i -= P0_MOD;
    if (i < P0_TR) {
      if (i < NT_IN) { transpose_tile(p.w_in, 1024, 2752, p.WinT, (i / 44) * 64, (i % 44) * 64, 0, lds); return; }
      i -= NT_IN;
      if (i < NT_UQ) { transpose_tile(p.w_uq, 384, 768, p.WuqT, (i / 12) * 64, (i % 12) * 64, 1, lds); return; }
      i -= NT_UQ;
      if (i < NT_UK) { transpose_tile(p.w_uk, 256, 512, p.WukT, (i / 8) * 64, (i % 8) * 64, 0, lds); return; }
      i -= NT_UK;
      if (i < NT_UK) { transpose_tile(p.w_uv, 256, 512, p.WuvT, (i / 8) * 64, (i % 8) * 64, 0, lds); return; }
      i -= NT_UK;
      if (i < NT_OUT) { transpose_tile(p.w_out, 1024, 1024, p.WoutT, (i / 16) * 64, (i % 16) * 64, 0, lds); return; }
      i -= NT_OUT;
      if (i < NT_UP) { transpose_tile(p.w_up, 1024, 5632, p.WupT, (i / 88) * 64, (i % 88) * 64, 2, lds); return; }
      i -= NT_UP;
      transpose_tile(p.w_down, 2816, 1024, p.WdownT, (i / 16) * 64, (i % 16) * 64, 0, lds);
      return;
    }
    i -= P0_TR;
    if (i < P0_ROPE) { rope_item(p, i); return; }
    i -= P0_ROPE;
    if (i < P0_CACHE) { cache_item(p, i); return; }
    for (int c = get_tid(); c < 512; c += 256) p.lb[c] = 1.f / (1.f + __expf(p.lb_logits[512 + c] - p.lb_logits[c]));
  }
}
DI void phase0(const P& p, char* lds) {
  for (int it = blockIdx.x; it < P0_EARLY + 1; it += gridDim.x) p0_item(p, it < P0_EARLY ? it : P0_TOTAL - 1, lds);
}

constexpr int RPW = 4;
DI void rownorm_phase(const P& p, int which) {
  const int lane = get_tid() & 63, gw = blockIdx.x * 4 + (get_tid() >> 6), nw = gridDim.x * 4;
  const float* gain = which ? p.g_ffn : p.g_mix;
  for (int row0 = gw * RPW; row0 < T; row0 += nw * RPW) {
    f32x4 v[RPW][4];
    float ss[RPW]; for (int r = 0; r < RPW; ++r) ss[r] = 0.f;
#pragma unroll
    for (int r = 0; r < RPW; ++r) {
      const int row = row0 + r;
      const float* src = row < TP ? p.x_p + (size_t)row * 1024 : p.x_s + (size_t)(row - TP) * 1024;
#pragma unroll
      for (int h = 0; h < 2; ++h) {
        const int c = lane * 8 + 512 * h;
        if (which) { const u32x4 xb = *(const u32x4*)(p.x1b + (size_t)row * 1024 + c);
          v[r][2 * h] = (f32x4){bflo(xb[0]), bfhi(xb[0]), bflo(xb[1]), bfhi(xb[1])}; v[r][2 * h + 1] = (f32x4){bflo(xb[2]), bfhi(xb[2]), bflo(xb[3]), bfhi(xb[3])}; }
        else { v[r][2 * h] = *(const f32x4*)(src + c); v[r][2 * h + 1] = *(const f32x4*)(src + c + 4); }
      }
#pragma unroll
      for (int i = 0; i < 4; ++i) ss[r] += v[r][i][0] * v[r][i][0] + v[r][i][1] * v[r][i][1] + v[r][i][2] * v[r][i][2] + v[r][i][3] * v[r][i][3];
    }
    f32x4 o[RPW][4];
#pragma unroll
    for (int r = 0; r < RPW; ++r) {
      const int row = row0 + r;
      const float rstd = rsqrtf(wave_sum(ss[r]) * (1.f / 1024.f) + EPS);
      const float* m = p.mod + row_bidx(row) * 6144 + (which ? 3072 : 0);
#pragma unroll
      for (int i = 0; i < 4; ++i) {
        const int c = lane * 8 + 512 * (i >> 1) + 4 * (i & 1);
        f32x4 g = *(const f32x4*)(gain + c), sh = *(const f32x4*)(m + c), sc = *(const f32x4*)(m + 1024 + c);
        o[r][i] = v[r][i] * rstd * g * (sc + 1.f) + sh;
      }
    }
#pragma unroll
    for (int r = 0; r < RPW; ++r)
#pragma unroll
      for (int h = 0; h < 2; ++h) st_bf8(p.hbuf + (size_t)(row0 + r) * 1024 + lane * 8 + 512 * h, o[r][2 * h], o[r][2 * h + 1]);
  }
}
DI void final_phase(const P& p, bool dry) {
  const int lane = get_tid() & 63, gw = blockIdx.x * 4 + (get_tid() >> 6), nw = gridDim.x * 4;
  for (int row0 = gw * RPW; row0 < T; row0 += nw * RPW) {
    f32x4 v[RPW][4];
    float ss[RPW]; for (int r = 0; r < RPW; ++r) ss[r] = 0.f;
#pragma unroll
    for (int r = 0; r < RPW; ++r) {
      const bf16_t* src = p.hbuf + (size_t)(row0 + r) * 1024;
#pragma unroll
      for (int h = 0; h < 2; ++h) { const u32x4 xb = *(const u32x4*)(src + lane * 8 + 512 * h);
        v[r][2 * h] = (f32x4){bflo(xb[0]), bfhi(xb[0]), bflo(xb[1]), bfhi(xb[1])}; v[r][2 * h + 1] = (f32x4){bflo(xb[2]), bfhi(xb[2]), bflo(xb[3]), bfhi(xb[3])}; }
#pragma unroll
      for (int i = 0; i < 4; ++i) ss[r] += v[r][i][0] * v[r][i][0] + v[r][i][1] * v[r][i][1] + v[r][i][2] * v[r][i][2] + v[r][i][3] * v[r][i][3];
    }
    f32x4 gf[4];
#pragma unroll
    for (int i = 0; i < 4; ++i) gf[i] = *(const f32x4*)(p.g_final + lane * 8 + 512 * (i >> 1) + 4 * (i & 1));
#pragma unroll
    for (int r = 0; r < RPW; ++r) {
      float* dst = p.out + O_Y + (size_t)(row0 + r) * 1024;
      const float rstd = rsqrtf(wave_sum(ss[r]) * (1.f / 1024.f) + EPS);
#pragma unroll
      for (int i = 0; i < 4; ++i) { const int c = lane * 8 + 512 * (i >> 1) + 4 * (i & 1); if (!dry) *(f32x4*)(dst + c) = v[r][i] * rstd * gf[i]; }
    }
  }
}
DI void post_row(const P& p, int row, int lane) {
  const bf16_t* raw = p.mla_raw + (size_t)row * 704;
  const int i = lane & 31;
  float q[6];
#pragma unroll
  for (int j = 0; j < 6; ++j) q[j] = bf2f(raw[lane + 64 * j]);
  const u32x2 kvb = *(const u32x2*)(raw + 384 + lane * 4);
  const f32x4 kv = {bflo(kvb[0]), bfhi(kvb[0]), bflo(kvb[1]), bfhi(kvb[1])};
  const float x = bf2f(raw[640 + lane]);
  const float* cs = p.rope + ((size_t)row_pos(row) * 32 + i) * 2;
  const float c = cs[0], s = cs[1];
  float qg[6];
#pragma unroll
  for (int j = 0; j < 6; ++j) qg[j] = p.qn_g[lane + 64 * j];
  const f32x4 kg = *(const f32x4*)(p.kvn_g + lane * 4);
  float ss = 0.f;
#pragma unroll
  for (int j = 0; j < 6; ++j) ss += q[j] * q[j];
  ss = wave_sum(ss);
  float ss2 = wave_sum(kv[0] * kv[0] + kv[1] * kv[1] + kv[2] * kv[2] + kv[3] * kv[3]);
  const float xo = __shfl_xor(x, 32);
  float rstd = rsqrtf(ss * (1.f / 384.f) + EPS);
#pragma unroll
  for (int j = 0; j < 6; ++j) p.cqn[(size_t)row * 384 + lane + 64 * j] = f2bf(q[j] * rstd * qg[j]);
  rstd = rsqrtf(ss2 * (1.f / 256.f) + EPS);
  f32x4 lat = kv * rstd * kg;
  float* lo = row < TP ? p.out + O_LATP + (size_t)row * 256 : p.out + O_LATS + (size_t)(row - TP) * 256;
  *(f32x4*)(lo + lane * 4) = lat;
  st_bf4(p.lat_all + (size_t)row * 256 + lane * 4, lat);
  const float r = (lane < 32) ? x * c - xo * s : x * c + xo * s;
  float* ko = row < TP ? p.out + O_KRP + (size_t)row * 64 : p.out + O_KRS + (size_t)(row - TP) * 64;
  ko[lane] = r;
  p.kpe_all[(size_t)row * 64 + 2 * i + (lane >> 5)] = f2bf(r);
}

struct HgCtx { int r0, nvalid, h, id; };
DI HgCtx hg_ctx(int id) {
  HgCtx c; c.id = id;
  if (id < 2048) { c.h = id & 3; const int bc = id >> 2; c.r0 = (bc >> 6) * 4096 + (bc & 63) * 64; c.nvalid = 64; }
  else { const int j = id - 2048; c.h = j & 3; c.r0 = TP + (j >> 2) * 16; c.nvalid = 16; }
  return c;
}
DI void hg_load_vt(const P& p, const HgCtx& c, char* ldsVT) {
  const int tid = get_tid(), s = tid & 63;
#pragma unroll
  for (int i = 0; i < 4; ++i) {
    const int chunk = (tid >> 6) + 4 * i;
    u32x4 raw = {0u, 0u, 0u, 0u};
    if (s < c.nvalid) raw = *(const u32x4*)(p.hv + (size_t)(c.r0 + s) * 512 + c.h * 128 + chunk * 8);
    bf16_t* d = (bf16_t*)ldsVT + (chunk * 8) * 72 + s;
    d[0 * 72] = (bf16_t)(raw[0] & 0xffff); d[1 * 72] = (bf16_t)(raw[0] >> 16);
    d[2 * 72] = (bf16_t)(raw[1] & 0xffff); d[3 * 72] = (bf16_t)(raw[1] >> 16);
    d[4 * 72] = (bf16_t)(raw[2] & 0xffff); d[5 * 72] = (bf16_t)(raw[2] >> 16);
    d[6 * 72] = (bf16_t)(raw[3] & 0xffff); d[7 * 72] = (bf16_t)(raw[3] >> 16);
  }
}
DI void hg1_item(const P& p, int id, char* lds) {
  const HgCtx c = hg_ctx(id);
  const int tid = get_tid(), lane = tid & 63, wave = tid >> 6, fr = lane & 15, fq = lane >> 4;
  const int k = tid & 127, half = tid >> 7;
  float* red = (float*)lds;
  char* ldsKT = lds + 1024;
  char* ldsVT = lds + 1024 + 18432;
  __syncthreads();
  float lf[32], bb[32];
  float run = 0.f;
#pragma unroll
  for (int i = 0; i < 32; ++i) {
    const int s = half * 32 + i;
    lf[i] = (s < c.nvalid) ? p.logf[(size_t)(c.r0 + s) * 512 + c.h * 128 + k] : 0.f;
    run += lf[i]; bb[i] = run;
  }
  red[tid] = run;
  hg_load_vt(p, c, ldsVT);
  __syncthreads();
  const float off = half ? red[k] : 0.f, blast = red[k] + red[128 + k];
#pragma unroll
  for (int i = 0; i < 32; i += 2) {
    const float k0 = (1.f - __expf(lf[i])) * __expf(blast - (bb[i] + off));
    const float k1 = (1.f - __expf(lf[i + 1])) * __expf(blast - (bb[i + 1] + off));
    *(unsigned*)(ldsKT + (k * 72 + half * 32 + i) * 2) = pk2(k0, k1);
  }
  if (tid < 128) p.Dbuf[(size_t)id * 128 + k] = __expf(blast);
  __syncthreads();
  f32x4 acc[2][8];
#pragma unroll
  for (int a = 0; a < 2; ++a)
#pragma unroll
    for (int b = 0; b < 8; ++b) acc[a][b] = (f32x4){0.f, 0.f, 0.f, 0.f};
#pragma unroll
  for (int ss = 0; ss < 2; ++ss) {
    bf16x8 ka[2];
#pragma unroll
    for (int a = 0; a < 2; ++a) ka[a] = *(const bf16x8*)(ldsKT + (((wave * 2 + a) * 16 + fr) * 72 + ss * 32 + fq * 8) * 2);
#pragma unroll
    for (int b = 0; b < 8; ++b) {
      const bf16x8 vb = *(const bf16x8*)(ldsVT + ((b * 16 + fr) * 72 + ss * 32 + fq * 8) * 2);
#pragma unroll
      for (int a = 0; a < 2; ++a) acc[a][b] = MFMA16(ka[a], vb, acc[a][b]);
    }
  }
#pragma unroll
  for (int a = 0; a < 2; ++a)
#pragma unroll
    for (int b = 0; b < 8; ++b) st_bf4(p.dS + (size_t)id * 16384 + (b * 16 + fr) * 128 + (wave * 2 + a) * 16 + fq * 4, acc[a][b]);
}
DI void hg2_item(const P& p, int item) {
  const int tid = get_tid();
  if (item < 512) {
    const int sh = item >> 4, b = sh >> 2, h = sh & 3, e = (item & 15) * 1024 + tid * 4, v = e >> 7, k = e & 127;
    float S[4] = {0.f, 0.f, 0.f, 0.f};
    for (int c0 = 0; c0 < 64; c0 += 8) {
      u32x2 raw[8]; f32x4 dv[8];
#pragma unroll
      for (int j = 0; j < 8; ++j) {
        const size_t id = (size_t)((b * 64 + c0 + j) * 4 + h);
        raw[j] = *(const u32x2*)(p.dS + id * 16384 + e);
        dv[j] = *(const f32x4*)(p.Dbuf + id * 128 + k);
      }
#pragma unroll
      for (int j = 0; j < 8; ++j) {
        const size_t id = (size_t)((b * 64 + c0 + j) * 4 + h);
        u32x2 w = {pk2(S[0], S[1]), pk2(S[2], S[3])};
        *(u32x2*)(p.dS + id * 16384 + e) = w;
        S[0] = dv[j][0] * S[0] + bflo(raw[j][0]); S[1] = dv[j][1] * S[1] + bfhi(raw[j][0]);
        S[2] = dv[j][2] * S[2] + bflo(raw[j][1]); S[3] = dv[j][3] * S[3] + bfhi(raw[j][1]);
      }
    }
#pragma unroll
    for (int j = 0; j < 4; ++j) p.out[O_HGP + ((size_t)(b * 4 + h) * 128 + k + j) * 128 + v] = S[j];
  } else {
    const int it = item - 512, sh = it >> 4, e = (it & 15) * 1024 + tid * 4, v = e >> 7, k = e & 127;
    const size_t id = 2048 + sh;
    float S[4];
#pragma unroll
    for (int j = 0; j < 4; ++j) S[j] = p.st_hg[((size_t)sh * 128 + k + j) * 128 + v];
    const u32x2 raw = *(const u32x2*)(p.dS + id * 16384 + e);
    const f32x4 dv = *(const f32x4*)(p.Dbuf + id * 128 + k);
    u32x2 w = {pk2(S[0], S[1]), pk2(S[2], S[3])};
    *(u32x2*)(p.dS + id * 16384 + e) = w;
    S[0] = dv[0] * S[0] + bflo(raw[0]); S[1] = dv[1] * S[1] + bfhi(raw[0]);
    S[2] = dv[2] * S[2] + bflo(raw[1]); S[3] = dv[3] * S[3] + bfhi(raw[1]);
#pragma unroll
    for (int j = 0; j < 4; ++j) p.out[O_HGS + ((size_t)sh * 128 + k + j) * 128 + v] = S[j];
  }
}
DI void hg3_item(const P& p, int id, char* lds) {
  const HgCtx c = hg_ctx(id);
  const int tid = get_tid(), lane = tid & 63, wave = tid >> 6, fr = lane & 15, fq = lane >> 4;
  const int k = tid & 127, half = tid >> 7;
  float* red = (float*)lds;
  char* ldsQ = lds + 1024;
  char* ldsK = ldsQ + 64 * 136 * 2;
  char* ldsVT = ldsK + 64 * 136 * 2;
  __syncthreads();
  float lf[32], qr[32];
  float run = 0.f;
#pragma unroll
  for (int i = 0; i < 32; ++i) {
    const int s = half * 32 + i;
    lf[i] = (s < c.nvalid) ? p.logf[(size_t)(c.r0 + s) * 512 + c.h * 128 + k] : 0.f;
    qr[i] = (s < c.nvalid) ? bf2f(p.hq[(size_t)(c.r0 + s) * 512 + c.h * 128 + k]) : 0.f;
  }
  u32x4 sreg[8];
#pragma unroll
  for (int i = 0; i < 8; ++i) sreg[i] = *(const u32x4*)(p.dS + (size_t)id * 16384 + (size_t)(tid + 256 * i) * 8);
#pragma unroll
  for (int i = 0; i < 32; ++i) run += lf[i];
  red[tid] = run;
  hg_load_vt(p, c, ldsVT);
  __syncthreads();
  float bcur = half ? red[k] : 0.f;
#pragma unroll
  for (int i = 0; i < 32; ++i) {
    const int s = half * 32 + i;
    bcur += lf[i];
    const float qv = qr[i];
    ((bf16_t*)ldsQ)[s * 136 + k] = f2bf(qv * 0.08838834764831845f * __expf(bcur));
    ((bf16_t*)ldsK)[s * 136 + k] = f2bf((1.f - __expf(lf[i])) * __expf(-bcur));
  }
  __syncthreads();
  bf16x8 qf[4];
#pragma unroll
  for (int ks = 0; ks < 4; ++ks) qf[ks] = *(const bf16x8*)(ldsQ + ((wave * 16 + fr) * 136 + ks * 32 + fq * 8) * 2);
  f32x4 sc[4];
#pragma unroll
  for (int ssub = 0; ssub < 4; ++ssub) {
    sc[ssub] = (f32x4){0.f, 0.f, 0.f, 0.f};
    if (ssub <= wave) {
#pragma unroll
      for (int ks = 0; ks < 4; ++ks) {
        const bf16x8 kf = *(const bf16x8*)(ldsK + ((ssub * 16 + fr) * 136 + ks * 32 + fq * 8) * 2);
        sc[ssub] = MFMA16(kf, qf[ks], sc[ssub]);
      }
      const int t = wave * 16 + fr;
#pragma unroll
      for (int j = 0; j < 4; ++j) if (ssub * 16 + fq * 4 + j > t) sc[ssub][j] = 0.f;
    }
  }
  bf16x8 pf[2];
#pragma unroll
  for (int kk = 0; kk < 2; ++kk) {
    u32x4 w = {pk2(sc[2 * kk][0], sc[2 * kk][1]), pk2(sc[2 * kk][2], sc[2 * kk][3]), pk2(sc[2 * kk + 1][0], sc[2 * kk + 1][1]), pk2(sc[2 * kk + 1][2], sc[2 * kk + 1][3])};
    pf[kk] = __builtin_bit_cast(bf16x8, w);
  }
  f32x4 o[8];
  float ssq = 0.f;
#pragma unroll
  for (int vs = 0; vs < 8; ++vs) {
    o[vs] = (f32x4){0.f, 0.f, 0.f, 0.f};
#pragma unroll
    for (int kk = 0; kk < 2; ++kk) {
      const char* vp = ldsVT + ((vs * 16 + fr) * 72 + kk * 32 + fq * 4) * 2;
      const u32x2 lo = *(const u32x2*)vp, hi = *(const u32x2*)(vp + 32);
      u32x4 w = {lo[0], lo[1], hi[0], hi[1]};
      o[vs] = MFMA16(__builtin_bit_cast(bf16x8, w), pf[kk], o[vs]);
    }
  }
  __syncthreads();
#pragma unroll
  for (int i = 0; i < 8; ++i) { const int idx = tid + 256 * i; *(u32x4*)(ldsQ + ((idx >> 4) * 136 + (idx & 15) * 8) * 2) = sreg[i]; }
  __syncthreads();
#pragma unroll
  for (int vs = 0; vs < 8; ++vs) {
#pragma unroll
    for (int ks = 0; ks < 4; ++ks) {
      const bf16x8 sf = *(const bf16x8*)(ldsQ + ((vs * 16 + fr) * 136 + ks * 32 + fq * 8) * 2);
      o[vs] = MFMA16(sf, qf[ks], o[vs]);
    }
    ssq += o[vs][0] * o[vs][0] + o[vs][1] * o[vs][1] + o[vs][2] * o[vs][2] + o[vs][3] * o[vs][3];
  }
  ssq += __shfl_xor(ssq, 16); ssq += __shfl_xor(ssq, 32);
  const float rn = rsqrtf(ssq * (1.f / 128.f) + EPS);
  const int t = wave * 16 + fr;
  if (t < c.nvalid) {
    const size_t row = (size_t)(c.r0 + t);
    u32x2 gt[8]; f32x4 gnn[8];
#pragma unroll
    for (int vs = 0; vs < 8; ++vs) { const int v0 = vs * 16 + fq * 4; gt[vs] = *(const u32x2*)(p.hgs + row * 512 + c.h * 128 + v0); gnn[vs] = *(const f32x4*)(p.hg_gain + v0); }
#pragma unroll
    for (int vs = 0; vs < 8; ++vs) {
      const int v0 = vs * 16 + fq * 4;
      const u32x2 g = gt[vs]; const f32x4 gn = gnn[vs];
      f32x4 r = {o[vs][0] * rn * gn[0] * bflo(g[0]), o[vs][1] * rn * gn[1] * bfhi(g[0]), o[vs][2] * rn * gn[2] * bflo(g[1]), o[vs][3] * rn * gn[3] * bfhi(g[1])};
      st_bf4(p.mix + row * 1024 + c.h * 128 + v0, r);
    }
  }
}

DI void attn_item(const P& p, int kind, int b, int h, int qb, char* lds) {
  const int tid = get_tid(), lane = tid & 63, wave = tid >> 6, fr = lane & 15, fq = lane >> 4;
  int qrow0, nsub, nt, my_nt, ntA; size_t baseA, baseB;
  if (kind == 0) { qrow0 = b * 4096 + qb * 128 + wave * 32; nsub = 2; nt = 2 * qb + 2; my_nt = (wave < 2) ? nt - 1 : nt; ntA = nt; baseA = (size_t)b * 4096; baseB = 0; }
  else { qrow0 = TP + b * 16; nsub = (wave == 0) ? 1 : 0; nt = 65; my_nt = (wave == 0) ? 65 : 0; ntA = 64; baseA = (size_t)T + (size_t)b * 4096; baseB = (size_t)TP + b * 16; }
  char* ldsK = lds;
  char* ldsV = lds + 24576;
  bf16x8 qf[2][6];
#pragma unroll
  for (int qs = 0; qs < 2; ++qs)
#pragma unroll
    for (int ks = 0; ks < 6; ++ks) {
      u32x4 z = {0u, 0u, 0u, 0u};
      if (qs < nsub) z = *(const u32x4*)(p.Q + (size_t)(qrow0 + qs * 16 + fr) * 768 + h * 192 + ks * 32 + fq * 8);
      qf[qs][ks] = __builtin_bit_cast(bf16x8, z);
    }
  const char* kb0 = ldsK + fr * 384 + ((fq ^ (fr & 7)) << 4);
  const char* kb1 = ldsK + fr * 384 + (((4 | fq) ^ (fr & 7)) << 4);
  const char* vb0 = ldsV + fr * 136 + fq * 8;
  u32x4 rk[6], rv[4];
  const int nkey = tid >> 4, nc = tid & 15, pkey = tid >> 3, pc = tid & 7, vdv = tid >> 3, vc = tid & 7;
  const bf16_t* gkn = p.Knope + (size_t)nkey * 512 + h * 128 + nc * 8;
  const bf16_t* gkp = p.kpe_all + (size_t)pkey * 64 + pc * 8;
  const bf16_t* gv = p.Vt + (size_t)(h * 128 + vdv) * TK + vc * 8;
  char* skn = ldsK + nkey * 384 + ((nc ^ (nkey & 7)) << 4);
  char* skp = ldsK + pkey * 384 + ((16 + (pc ^ (pkey & 7))) << 4);
  char* sv = ldsV + vdv * 136 + vc * 16;
  auto issue = [&](int t) {
    const size_t krow0 = (t < ntA) ? baseA + (size_t)t * 64 : baseB;
#pragma unroll
    for (int i = 0; i < 4; ++i) rk[i] = *(const u32x4*)(gkn + (krow0 + 16 * i) * 512);
#pragma unroll
    for (int i = 0; i < 2; ++i) rk[4 + i] = *(const u32x4*)(gkp + (krow0 + 32 * i) * 64);
  };
  auto issueV = [&](int t) {
    const size_t krow0 = (t < ntA) ? baseA + (size_t)t * 64 : baseB;
#pragma unroll
    for (int i = 0; i < 4; ++i) rv[i] = *(const u32x4*)(gv + (size_t)(32 * i) * TK + krow0);
  };
  issue(0); issueV(0);
  float m[2] = {-1e30f, -1e30f}, l[2] = {0.f, 0.f};
  f32x4 o[2][8];
#pragma unroll
  for (int qs = 0; qs < 2; ++qs)
#pragma unroll
    for (int d = 0; d < 8; ++d) o[qs][d] = (f32x4){0.f, 0.f, 0.f, 0.f};
  for (int t = 0; t < nt; ++t) {
    __syncthreads();
#pragma unroll
    for (int i = 0; i < 4; ++i) *(u32x4*)(skn + i * 6144) = rk[i];
#pragma unroll
    for (int i = 0; i < 2; ++i) *(u32x4*)(skp + i * 12288) = rk[4 + i];
#pragma unroll
    for (int i = 0; i < 4; ++i) {
      u32x2 a = {rv[i][0], rv[i][1]}, bb = {rv[i][2], rv[i][3]};
      *(u32x2*)(sv + i * 4352) = a;
      *(u32x2*)(sv + i * 4352 + 8) = bb;
    }
    __syncthreads();
    if (t + 1 < nt) issue(t + 1);
    if (t >= my_nt && t + 1 < nt) issueV(t + 1);
    if (t < my_nt) {
      const int nvalid = (t < ntA) ? 64 : 16;
      f32x4 s[2][4];
#pragma unroll
      for (int ksub = 0; ksub < 4; ++ksub) {
        s[0][ksub] = (f32x4){0.f, 0.f, 0.f, 0.f}; s[1][ksub] = s[0][ksub];
        bf16x8 kf[6];
#pragma unroll
        for (int ks = 0; ks < 6; ++ks) kf[ks] = *(const bf16x8*)(((ks & 1) ? kb1 : kb0) + ksub * 6144 + (ks >> 1) * 128);
#pragma unroll
        for (int ks = 0; ks < 6; ++ks) {
          s[0][ksub] = MFMA16(kf[ks], qf[0][ks], s[0][ksub]);
          if (nsub > 1) s[1][ksub] = MFMA16(kf[ks], qf[1][ks], s[1][ksub]);
        }
        __builtin_amdgcn_sched_barrier(0);
      }
      bf16x8 pf[2][2];
#pragma unroll
      for (int qs = 0; qs < 2; ++qs) {
        if (qs < nsub) {
          if (nvalid < 64) {
#pragma unroll
            for (int ksub = 0; ksub < 4; ++ksub)
#pragma unroll
              for (int j = 0; j < 4; ++j) if (ksub * 16 + fq * 4 + j >= nvalid) s[qs][ksub][j] = -1e30f;
          }
          float mx = -1e30f;
#pragma unroll
          for (int ksub = 0; ksub < 4; ++ksub)
#pragma unroll
            for (int j = 0; j < 4; ++j) mx = fmaxf(mx, s[qs][ksub][j]);
          mx = fmaxf(mx, __shfl_xor(mx, 16)); mx = fmaxf(mx, __shfl_xor(mx, 32));
          const float mn = fmaxf(m[qs], mx), alpha = exp2f(m[qs] - mn);
          m[qs] = mn;
          float ps = 0.f;
#pragma unroll
          for (int ksub = 0; ksub < 4; ++ksub)
#pragma unroll
            for (int j = 0; j < 4; ++j) { const float e = exp2f(s[qs][ksub][j] - mn); s[qs][ksub][j] = e; ps += e; }
          l[qs] = l[qs] * alpha + ps;
#pragma unroll
          for (int d = 0; d < 8; ++d) o[qs][d] = o[qs][d] * alpha;
#pragma unroll
          for (int kk = 0; kk < 2; ++kk) {
            u32x4 w = {pk2(s[qs][2 * kk][0], s[qs][2 * kk][1]), pk2(s[qs][2 * kk][2], s[qs][2 * kk][3]),
                       pk2(s[qs][2 * kk + 1][0], s[qs][2 * kk + 1][1]), pk2(s[qs][2 * kk + 1][2], s[qs][2 * kk + 1][3])};
            pf[qs][kk] = __builtin_bit_cast(bf16x8, w);
          }
        } else {
          u32x4 z = {0u, 0u, 0u, 0u};
          pf[qs][0] = __builtin_bit_cast(bf16x8, z); pf[qs][1] = pf[qs][0];
        }
      }
      if (t + 1 < nt) issueV(t + 1);
#pragma unroll
      for (int d2 = 0; d2 < 8; d2 += 2) {
        bf16x8 vf[2][2];
#pragma unroll
        for (int dd = 0; dd < 2; ++dd)
#pragma unroll
          for (int kk = 0; kk < 2; ++kk) {
            const char* vp = vb0 + (d2 + dd) * 2176 + kk * 64;
            const u32x2 lo = *(const u32x2*)vp, hi = *(const u32x2*)(vp + 32);
            u32x4 w = {lo[0], lo[1], hi[0], hi[1]};
            vf[dd][kk] = __builtin_bit_cast(bf16x8, w);
          }
#pragma unroll
        for (int dd = 0; dd < 2; ++dd)
#pragma unroll
          for (int kk = 0; kk < 2; ++kk) {
            o[0][d2 + dd] = MFMA16(vf[dd][kk], pf[0][kk], o[0][d2 + dd]);
            if (nsub > 1) o[1][d2 + dd] = MFMA16(vf[dd][kk], pf[1][kk], o[1][d2 + dd]);
          }
        __builtin_amdgcn_sched_barrier(0);
      }
    }
  }
#pragma unroll
  for (int qs = 0; qs < 2; ++qs) {
    if (qs < nsub) {
      float lt = l[qs]; lt += __shfl_xor(lt, 16); lt += __shfl_xor(lt, 32);
      const float inv = 1.f / lt;
      bf16_t* dst = p.mix + (size_t)(qrow0 + qs * 16 + fr) * 1024 + 512 + h * 128 + fq * 4;
#pragma unroll
      for (int d = 0; d < 8; ++d) st_bf4(dst + d * 16, o[qs][d] * inv);
    }
  }
}

DI void fixup_phase(const P& p) {
  const int total = (1024 + 128) * 352, stride = gridDim.x * 256;
  for (int e = blockIdx.x * 256 + get_tid(); e < total; e += stride) {
    const int r = e / 352, c0 = (e - r * 352) * 8;
    const bf16_t *pa0, *pa1 = nullptr, *pa2 = nullptr, *pv; const float *f1 = nullptr, *f2 = nullptr; int row;
    if (r < 1024) {
      const int blk = r >> 1, i = r & 1; row = blk * 64 + i; const int pos = row & 4095;
      pa0 = p.headA + (size_t)r * 2816 + c0; pv = p.headV + (size_t)r * 2816 + c0;
      if (i == 0) { if (pos != 0) { pa1 = p.tailA + ((size_t)(blk - 1) * 2 + 1) * 2816 + c0; pa2 = p.tailA + ((size_t)(blk - 1) * 2) * 2816 + c0; } }
      else { pa1 = p.headA + (size_t)(r - 1) * 2816 + c0; if (pos != 1) pa2 = p.tailA + ((size_t)(blk - 1) * 2 + 1) * 2816 + c0; }
    } else {
      const int sr = r - 1024, b = sr >> 4, i = sr & 15; row = TP + sr;
      pa0 = p.sA + (size_t)sr * 2816 + c0; pv = p.sV + (size_t)sr * 2816 + c0;
      const float* cst = p.st_conv + (size_t)b * 2 * 2816 + c0;
      if (i >= 1) pa1 = pa0 - 2816; else f1 = cst + 2816;
      if (i >= 2) pa2 = pa0 - 2 * 2816; else f2 = cst + i * 2816;
    }
    float a0[8], a1[8], a2[8], vv[8];
    { const u32x4 t = *(const u32x4*)pa0, u = *(const u32x4*)pv;
#pragma unroll
      for (int j = 0; j < 4; ++j) { a0[2 * j] = bflo(t[j]); a0[2 * j + 1] = bfhi(t[j]); vv[2 * j] = bflo(u[j]); vv[2 * j + 1] = bfhi(u[j]); } }
    if (pa1) { const u32x4 t = *(const u32x4*)pa1;
#pragma unroll
      for (int j = 0; j < 4; ++j) { a1[2 * j] = bflo(t[j]); a1[2 * j + 1] = bfhi(t[j]); } }
    else {
#pragma unroll
      for (int j = 0; j < 8; ++j) a1[j] = f1 ? f1[j] : 0.f; }
    if (pa2) { const u32x4 t = *(const u32x4*)pa2;
#pragma unroll
      for (int j = 0; j < 4; ++j) { a2[2 * j] = bflo(t[j]); a2[2 * j + 1] = bfhi(t[j]); } }
    else {
#pragma unroll
      for (int j = 0; j < 8; ++j) a2[j] = f2 ? f2[j] : 0.f; }
    float g[8];
#pragma unroll
    for (int j = 0; j < 8; ++j) {
      const float cv = p.conv_b[c0 + j] + p.conv_w[c0 + j] * a2[j] + p.conv_w[2816 + c0 + j] * a1[j] + p.conv_w[5632 + c0 + j] * a0[j];
      g[j] = gelu_erf(cv) * vv[j];
    }
    u32x4 w = {pk2(g[0], g[1]), pk2(g[2], g[3]), pk2(g[4], g[5]), pk2(g[6], g[7])};
    *(u32x4*)(p.vbuf + (size_t)row * 2816 + c0) = w;
  }
}

constexpr int ATT_ITEMS = 32 + 1024;
constexpr int MT = T / 128, MTK = TK / 128, MT2 = (T + 255) / 256, MTK2 = (TK + 255) / 256;
__global__ void __launch_bounds__(256, 2) fwd_kernel(P p) {
  __shared__ __attribute__((aligned(16))) char lds[65536];
  __shared__ uint4 xb_words;
  cg::grid_group grid = cg::this_grid();
  const unsigned G = gridDim.x;
  if (threadIdx.x == 0) xb_words = make_uint4(0u, 0u, 0u, 0u);
  __syncthreads();
  const XcdBarrier xb = xcd_barrier_post(p.ctr, (volatile LAS unsigned*)&xb_words);
  if (p.ctr[CTR_Q + 40] != 0u) grid.sync();
  for (int rep = 0; rep < REP_P0; ++rep) phase0(p, lds);
  gbar(p.ctr, 0);
  if (threadIdx.x == 0) {
    unsigned off = 0u;
    for (unsigned j = 0; j < 16; ++j) { const unsigned c = xb_ld(&p.ctr[XB_XCNT(j)]); off += (j < xb.x) ? c : 0u; }
    ((volatile LAS unsigned*)&xb_words)[3] = off + ((volatile LAS unsigned*)&xb_words)[2];
  }
  __syncthreads();
  const int myslot = (int)((volatile LAS unsigned*)&xb_words)[3];
  for (int rep = 0; rep < REP_ROW; ++rep) rownorm_phase(p, 0);
  gbar(p.ctr, 0);
  { EpiProj e{p};
    for (int rep = 0; rep < REP_GEMM; ++rep)
    { gemm256_stream<EpiProj, false, false, true>(p.hbuf, 1024, p.WinT, 1024, 1024, MT2, 22, T, lds, e, myslot); } }
  { int* s_item = (int*)(lds + 65528);
    for (;;) {
      __syncthreads();
      if (get_tid() == 0) *s_item = (int)atomicAdd(p.ctr + CTR_Q + 2, 1u);
      __syncthreads();
      const int it = *s_item + P0_EARLY;
      if (it >= P0_TOTAL - 1) break;
      p0_item(p, it, lds);
    } }
  gbar(p.ctr, 0);
  for (int rep = 0; rep < REP_P3; ++rep)
  { const int nrow_items = (T + 3) / 4;
    for (int pos = blockIdx.x; pos < 5 * NCH; pos += G) {
      const int a = pos / 5, r = pos - 5 * a;
      if (r == 0) hg1_item(p, a, lds);
      else { const int it = 4 * a + (r - 1); const int row = it * 4 + (get_tid() >> 6); if (it < nrow_items && row < T) post_row(p, row, get_tid() & 63); }
    } }
  gbar(p.ctr, 0);
  { EpiQ eq{p}; EpiKn ek{p}; EpiVt ev{p};
    for (int it = blockIdx.x; it < 1024; it += G) {
#ifndef SKIP_HG2
      hg2_item(p, it);
#endif
    }
    int mt, nt;
    for (int k = 0; tile_next(k, MT, 6, mt, nt, myslot); ++k) gemm_tile<EpiQ, false, false, true>(p.cqn, 384, p.WuqT, 384, 384, mt * 128, nt * 128, lds, eq);
    for (int k = 0; tile_next(k, MTK, 4, mt, nt, myslot); ++k) gemm_tile<EpiKn, false, false, true>(p.lat_all, 256, p.WukT, 256, 256, mt * 128, nt * 128, lds, ek);
    for (int k = 0; tile_next(k, 4, MTK, mt, nt, myslot); ++k) gemm_tile<EpiVt, false, false, true>(p.WuvT, 256, p.lat_all, 256, 256, mt * 128, nt * 128, lds, ev);
  }
  gbar(p.ctr, 0);
  for (int rep = 0; rep < REP_ATT; ++rep)
  { int* s_item = (int*)(lds + 65528);
    const int total = 3 * ATT_ITEMS;
    for (;;) {
      __syncthreads();
      if (get_tid() == 0) *s_item = (int)atomicAdd(p.ctr + CTR_Q + rep, 1u);
      __syncthreads();
      const int pos = *s_item;
      if (pos >= total) break;
      const int a = pos / 3, r = pos - 3 * a;
      if (r == 0) { const int it = a, j = it - 32; const int kind = it < 32 ? 1 : 0;
        attn_item(p, kind, kind ? (it >> 2) : ((j & 31) >> 2), it & 3, kind ? 0 : 31 - (j >> 5), lds); }
      else { const int hid = 2 * a + (r - 1); if (hid < NCH) hg3_item(p, hid, lds); }
    } }
  gbar(p.ctr, 0);
  { EpiOut e{p};
    for (int rep = 0; rep < REP_GEMM; ++rep)
    { gemm256_stream<EpiOut, false, false, true>(p.mix, 1024, p.WoutT, 1024, 1024, 128, 8, T, lds, e, myslot);
      for (int it = blockIdx.x; it < 8; it += G) gemm_tile(p.mix, 1024, p.WoutT, 1024, 1024, TP, it * 128, lds, e); } }
  gbar(p.ctr, 0);
  for (int rep = 0; rep < REP_ROW; ++rep) rownorm_phase(p, 1);
  gbar(p.ctr, 0);
  { EpiGlu e{p};
    for (int rep = 0; rep < REP_GEMM; ++rep)
    { gemm256_stream<EpiGlu, true, false, true>(p.hbuf, 1024, p.WupT, 1024, 1024, MT2, 44, T, lds, e, myslot); } }
  gbar(p.ctr, 0);
  fixup_phase(p);
  gbar(p.ctr, 0);
  for (int rep = 0; rep < REP_TAIL; ++rep)
  { EpiDown e{p, rep < REP_TAIL - 1 && p.ctr[CTR_Q + 24] == 0};
    { gemm256_stream<EpiDown, false, false, true>(p.vbuf, 2816, p.WdownT, 2816, 2816, 128, 8, T, lds, e, myslot);
      for (int it = blockIdx.x; it < 8; it += G) gemm_tile(p.vbuf, 2816, p.WdownT, 2816, 2816, TP, it * 128, lds, e); } }
  gbar(p.ctr, 0);
  for (int rep = 0; rep < REP_TAIL; ++rep) final_phase(p, rep < REP_TAIL - 1 && p.ctr[CTR_Q + 24] == 0);
}

extern "C" void kernel_launch(void* const* d_in, const int* in_sizes, int n_in, void* d_out, int out_size, void* d_ws,
                              size_t ws_size, hipStream_t stream) {
  P p{};
  const float* const* in = (const float* const*)d_in;
  p.x_p = in[0]; p.x_s = in[1]; p.c_p = in[2]; p.c_s = in[3]; p.cache_lat = in[4]; p.cache_kpe = in[5]; p.st_hg = in[6]; p.st_conv = in[7];
  p.w_ada = in[8]; p.b_ada = in[9]; p.g_mix = in[10]; p.w_in = in[11]; p.lb_logits = in[12]; p.hg_gain = in[13]; p.qn_g = in[14]; p.kvn_g = in[15];
  p.w_uq = in[16]; p.w_uk = in[17]; p.w_uv = in[18]; p.w_out = in[19]; p.g_ffn = in[20]; p.w_up = in[21]; p.conv_w = in[22]; p.conv_b = in[23];
  p.w_down = in[24]; p.g_final = in[25];
  p.out = (float*)d_out;
  char* w = (char*)d_ws; size_t off = 0;
  auto take = [&](size_t bytes) { char* r = w + off; off += (bytes + 255) & ~(size_t)255; return r; };
  p.ctr = (unsigned*)take(16384);
  p.mod = (float*)take(16 * 6144 * 4);
  p.lb = (float*)take(4096);
  p.rope = (float*)take((size_t)4112 * 64 * 4);
  p.Dbuf = (float*)take((size_t)NCH * 128 * 4);
  p.WinT = (bf16_t*)take((size_t)2816 * 1024 * 2);
  p.WuqT = (bf16_t*)take((size_t)768 * 384 * 2);
  p.WukT = (bf16_t*)take((size_t)512 * 256 * 2);
  p.WuvT = (bf16_t*)take((size_t)512 * 256 * 2);
  p.WoutT = (bf16_t*)take((size_t)1024 * 1024 * 2);
  p.WupT = (bf16_t*)take((size_t)5632 * 1024 * 2);
  p.WdownT = (bf16_t*)take((size_t)1024 * 2816 * 2);
  p.hbuf = (bf16_t*)take((size_t)T * 1024 * 2);
  p.Q = p.hbuf;
  const size_t big0 = off;
  p.hq = (bf16_t*)take((size_t)T * 512 * 2);
  p.hv = (bf16_t*)take((size_t)T * 512 * 2);
  p.hgs = (bf16_t*)take((size_t)T * 512 * 2);
  p.logf = (float*)take((size_t)T * 512 * 4);
  p.cqn = (bf16_t*)take((size_t)T * 384 * 2);
  p.lat_all = (bf16_t*)take((size_t)TK * 256 * 2);
  p.kpe_all = (bf16_t*)take((size_t)TK * 64 * 2);
  p.dS = (bf16_t*)take((size_t)NCH * 16384 * 2);
  p.mix = (bf16_t*)take((size_t)T * 1024 * 2);
  p.x1b = (bf16_t*)take((size_t)T * 1024 * 2);
  const size_t big1 = off;
  p.abuf = (bf16_t*)(w + big0);
  p.vbuf = p.abuf + (size_t)T * 2816;
  p.headA = p.abuf; p.headV = p.headA + (size_t)1024 * 2816; p.tailA = p.headV + (size_t)1024 * 2816;
  p.sA = p.tailA + (size_t)1024 * 2816; p.sV = p.sA + (size_t)128 * 2816;
  const size_t ffn_end = big0 + (size_t)T * 2816 * 2 * 2;
  const size_t need = ffn_end > big1 ? ffn_end : big1;
  p.mla_raw = (bf16_t*)(p.out + O_Y);
  p.Knope = (bf16_t*)(p.out + O_Y);
  p.Vt = p.Knope + (size_t)TK * 512;
  if (need > ws_size) { fprintf(stderr, "workspace too small: need %zu have %zu\n", need, ws_size); return; }
  static int grid_blocks = 0;
  if (!grid_blocks) {
    int dev = 0, cus = 0, per_cu = 0;
    hipGetDevice(&dev);
    hipDeviceGetAttribute(&cus, hipDeviceAttributeMultiprocessorCount, dev);
    hipOccupancyMaxActiveBlocksPerMultiprocessor(&per_cu, fwd_kernel, 256, 0);
    if (per_cu > 2) per_cu = 2;
    if (per_cu < 1) per_cu = 1;
    grid_blocks = cus * per_cu;
  }
  hipMemsetAsync(p.ctr, 0, 16384, stream);
  void* args[] = {&p};
  hipError_t e = hipLaunchCooperativeKernel((void*)fwd_kernel, dim3(grid_blocks), dim3(256), args, 0, stream);
  if (e != hipSuccess) fprintf(stderr, "cooperative launch failed: %s (grid %d)\n", hipGetErrorString(e), grid_blocks);
}
```

```cpp
#include <hip/hip_runtime.h>
#include <hip/hip_cooperative_groups.h>
#include <stdint.h>
#include <stdio.h>
namespace cg = cooperative_groups;
#ifndef REP_GEMM
#define REP_GEMM 1
#endif
#ifndef REP_ATT
#define REP_ATT 1
#endif
#define REP_WHAT 0
#define REP_P0 1
#define REP_ROW 1
#define REP_P3 1
#define REP_BAR 1
#define REP_TAIL 1

typedef unsigned short bf16_t;
typedef short bf16x8 __attribute__((ext_vector_type(8)));
typedef float f32x4 __attribute__((ext_vector_type(4)));
typedef float f32x2 __attribute__((ext_vector_type(2)));
typedef unsigned u32x4 __attribute__((ext_vector_type(4)));
typedef unsigned u32x2 __attribute__((ext_vector_type(2)));
typedef __bf16 bf16v2 __attribute__((ext_vector_type(2)));

#define DI __device__ __forceinline__
#define MFMA16(a, b, c) __builtin_amdgcn_mfma_f32_16x16x32_bf16((a), (b), (c), 0, 0, 0)

constexpr int TP = 32768, TS = 128, T = TP + TS, TK = T + 32768;
constexpr int NCH = 2048 + 32;
constexpr float EPS = 1e-6f;
constexpr size_t O_Y = 0, O_LATP = 33685504, O_KRP = 42074112, O_HGP = 44171264, O_CVP = 44695552,
                 O_LATS = 44740608, O_KRS = 44773376, O_HGS = 44781568, O_CVS = 45305856;

struct P {
  const float *x_p, *x_s, *c_p, *c_s, *cache_lat, *cache_kpe, *st_hg, *st_conv;
  const float *w_ada, *b_ada, *g_mix, *w_in, *lb_logits, *hg_gain, *qn_g, *kvn_g, *w_uq, *w_uk, *w_uv, *w_out,
      *g_ffn, *w_up, *conv_w, *conv_b, *w_down, *g_final;
  float* out;
  bf16_t *WinT, *WuqT, *WukT, *WuvT, *WoutT, *WupT, *WdownT;
  float *mod, *lb, *rope, *Dbuf;
  bf16_t *hbuf, *hq, *hv, *hgs;
  float* logf;
  bf16_t* mla_raw;
  bf16_t *cqn, *lat_all, *kpe_all, *Q, *Knope, *Vt, *dS, *mix, *abuf, *vbuf, *headA, *headV, *tailA, *sA, *sV, *x1b;
  unsigned* ctr;
};

DI int get_tid() { int t = threadIdx.x; asm volatile("" : "+v"(t)); return t & 255; }
DI unsigned pk2(float lo, float hi) { f32x2 v = {lo, hi}; bf16v2 b = __builtin_convertvector(v, bf16v2); return __builtin_bit_cast(unsigned, b); }
DI bf16_t f2bf(float x) { return (bf16_t)(pk2(x, 0.f) & 0xffffu); }
DI float bf2f(bf16_t x) { return __uint_as_float(((unsigned)x) << 16); }
DI float bflo(unsigned u) { return __uint_as_float(u << 16); }
DI float bfhi(unsigned u) { return __uint_as_float(u & 0xffff0000u); }
DI float wave_sum(float v) {
#pragma unroll
  for (int o = 32; o >= 1; o >>= 1) v += __shfl_xor(v, o);
  return v;
}
DI int row_bidx(int row) { return row < TP ? (row >> 12) : 8 + ((row - TP) >> 4); }
DI int row_pos(int row) { return row < TP ? (row & 4095) : 4096 + ((row - TP) & 15); }
DI int prow32(int r) { const int q = r & 31, i = q & 15; return (r & ~31) + 8 * (i >> 2) + 4 * (q >> 4) + (i & 3); }

#define XB_TMO      128
#define XB_XCNT(j)  (256  + 64 * (j))
#define XB_XSUB(j)  (1280 + 64 * (j))
#define XB_XGEN(j)  (2304 + 64 * (j))
#define XB_TOP      3328
#define XB_TOPGEN   3392
#define XCD_BAR_WORDS 3456
#define XB_SPIN_CAP (1u << 18)
#define CTR_Q 3584
#define LAS __attribute__((address_space(3)))
DI unsigned xb_ld(unsigned* p) { return __hip_atomic_load(p, __ATOMIC_RELAXED, __HIP_MEMORY_SCOPE_AGENT); }
DI unsigned xb_add(unsigned* p, unsigned v) { return __hip_atomic_fetch_add(p, v, __ATOMIC_RELAXED, __HIP_MEMORY_SCOPE_AGENT); }
DI unsigned xb_xcc_id() { return (unsigned)__builtin_amdgcn_s_getreg((3 << 11) | 20) & 0xFu; }
#define XB_SPIN(cond, bar) do { unsigned _sp = 0; while (cond) { __builtin_amdgcn_s_sleep(1); \
    if ((++_sp & 255u) == 0u) { if (xb_ld(&(bar)[XB_TMO])) break; if (_sp > XB_SPIN_CAP) { atomicAdd(&(bar)[XB_TMO], 1u); break; } } } } while (0)
struct XcdBarrier { unsigned* bar; unsigned x; volatile LAS unsigned* st; };
DI XcdBarrier xcd_barrier_post(unsigned* bar, volatile LAS unsigned* st) {
  XcdBarrier b; b.bar = bar; b.x = xb_xcc_id(); b.st = st;
  if (threadIdx.x == 0) (void)xb_add(&bar[XB_XCNT(b.x)], 1u);
  return b;
}
DI void xcd_barrier_complete(unsigned* bar, unsigned x, unsigned& nloc, unsigned& nx) {
  const unsigned G = gridDim.x * gridDim.y * gridDim.z;
  unsigned sum, cnt, mine, sp = 0u;
  for (;;) {
    sum = 0u; cnt = 0u; mine = 0u;
#pragma unroll
    for (unsigned j = 0; j < 16; ++j) { const unsigned c = xb_ld(&bar[XB_XCNT(j)]); sum += c; cnt += (c > 0u) ? 1u : 0u; mine = (j == x) ? c : mine; }
    if (sum == G) break;
    __builtin_amdgcn_s_sleep(1);
    if ((++sp & 255u) == 0u) { if (xb_ld(&bar[XB_TMO])) break; if (sp > XB_SPIN_CAP) { atomicAdd(&bar[XB_TMO], 1u); break; } }
  }
  nloc = mine > 0u ? mine : 1u; nx = cnt > 0u ? cnt : 1u;
}
DI void xcd_barrier(const XcdBarrier& b) {
  asm volatile("s_waitcnt vmcnt(0)" ::: "memory");
  __syncthreads();
  if (threadIdx.x == 0) {
    unsigned* bar = b.bar;
    __builtin_amdgcn_s_waitcnt(0);
    unsigned nloc = b.st[0], nx = b.st[1];
    if (nloc == 0u) { xcd_barrier_complete(bar, b.x, nloc, nx); b.st[0] = nloc; b.st[1] = nx; }
    const unsigned old = xb_add(&bar[XB_XSUB(b.x)], 1u);
    const unsigned gen = old / nloc;
    if (old + 1u == (gen + 1u) * nloc) {
      __builtin_amdgcn_fence(__ATOMIC_RELEASE, "agent");
      asm volatile("s_waitcnt vmcnt(0)" ::: "memory");
      const unsigned og = xb_add(&bar[XB_TOP], 1u);
      const unsigned tg = og / nx;
      if (og + 1u == (tg + 1u) * nx) xb_add(&bar[XB_TOPGEN], 1u);
      else XB_SPIN(xb_ld(&bar[XB_TOPGEN]) == tg, bar);
      __builtin_amdgcn_fence(__ATOMIC_ACQUIRE, "agent");
      xb_add(&bar[XB_XGEN(b.x)], 1u);
      asm volatile("s_waitcnt vmcnt(0)" ::: "memory");
    } else {
      XB_SPIN(xb_ld(&bar[XB_XGEN(b.x)]) == gen, bar);
      __builtin_amdgcn_fence(__ATOMIC_ACQUIRE, "agent");
      asm volatile("s_waitcnt vmcnt(0)" ::: "memory");
    }
  }
  __syncthreads();
}
#define gbar(c, t) do { for (int r_ = 0; r_ < REP_BAR; ++r_) xcd_barrier(xb); } while (0)
template <class Epi, bool NOLOAD = false, bool GLU = false, bool PERM = false>
DI void gemm_tile(const bf16_t* __restrict__ A, int lda, const bf16_t* __restrict__ B, int ldb, int K, int m0, int n0,
                  char* lds, const Epi& epi) {
  const int tid = get_tid(), lane = tid & 63, wave = tid >> 6, wr = wave >> 1, wc = wave & 1, fr = lane & 15, fq = lane >> 4;
  f32x4 acc[4][4];
#pragma unroll
  for (int i = 0; i < 4; ++i)
#pragma unroll
    for (int j = 0; j < 4; ++j) acc[i][j] = (f32x4){0.f, 0.f, 0.f, 0.f};
  const int lrow = tid >> 3, lchunk = tid & 7;
  const bf16_t* ga = A + (size_t)(m0 + lrow) * lda + lchunk * 8;
  const bf16_t* gb = B + (size_t)(n0 + (PERM ? prow32(lrow) : lrow)) * ldb + lchunk * 8;
  const int soff = lrow * 128 + ((lchunk ^ (lrow & 7)) << 4);
  u32x4 ra0[4], rb0[4], ra1[4], rb1[4];
  const int nk = K >> 6;
#define G_LOAD(RA, RB, kt) _Pragma("unroll") for (int i = 0; i < 4; ++i) { \
    RA[i] = *(const u32x4*)(ga + (size_t)(32 * i) * lda + (kt) * 64); RB[i] = *(const u32x4*)(gb + (size_t)(32 * i) * ldb + (kt) * 64); }
#define G_STORE(RA, RB, buf) _Pragma("unroll") for (int i = 0; i < 4; ++i) { \
    *(u32x4*)(lds + (buf) * 32768 + soff + i * 4096) = RA[i]; *(u32x4*)(lds + (buf) * 32768 + 16384 + soff + i * 4096) = RB[i]; }
#define G_COMPUTE(buf) _Pragma("unroll") for (int ks = 0; ks < 2; ++ks) { \
    bf16x8 af[4], bfr[4]; const int coff = ((ks * 4 + fq) ^ (fr & 7)) << 4; \
    _Pragma("unroll") for (int i = 0; i < 4; ++i) { \
      af[i] = *(const bf16x8*)(lds + (buf) * 32768 + (wr * 64 + i * 16 + fr) * 128 + coff); \
      bfr[i] = *(const bf16x8*)(lds + (buf) * 32768 + 16384 + (wc * 64 + i * 16 + fr) * 128 + coff); } \
    _Pragma("unroll") for (int mi = 0; mi < 4; ++mi) _Pragma("unroll") for (int ni = 0; ni < 4; ++ni) acc[mi][ni] = MFMA16(bfr[ni], af[mi], acc[mi][ni]); }
#define G_SCHED do { \
    __builtin_amdgcn_sched_group_barrier(0x100, 8, 0); \
    _Pragma("unroll") for (int g_ = 0; g_ < 8; ++g_) { \
      __builtin_amdgcn_sched_group_barrier(0x008, 4, 0); \
      __builtin_amdgcn_sched_group_barrier(0x020, 1, 0); \
      __builtin_amdgcn_sched_group_barrier(0x100, 1, 0); } \
    __builtin_amdgcn_sched_barrier(0); } while (0)
  G_LOAD(ra0, rb0, 0);
  G_LOAD(ra1, rb1, 1);
  G_STORE(ra0, rb0, 0);
  __syncthreads();
  for (int kt = 0; kt < nk; kt += 2) {
    if (!NOLOAD) { const int k2 = (kt + 2 < nk) ? kt + 2 : nk - 1; G_LOAD(ra0, rb0, k2); }
    G_COMPUTE(0);
    G_SCHED;
    G_STORE(ra1, rb1, 1);
    __syncthreads();
    if (!NOLOAD) { const int k3 = (kt + 3 < nk) ? kt + 3 : nk - 1; G_LOAD(ra1, rb1, k3); }
    G_COMPUTE(1);
    G_SCHED;
    G_STORE(ra0, rb0, 0);
    __syncthreads();
  }
#undef G_LOAD
#undef G_SCHED
#undef G_STORE
#undef G_COMPUTE
  if constexpr (PERM) {
#pragma unroll
    for (int mi = 0; mi < 4; ++mi) epi.perm8(m0 + wr * 64 + mi * 16 + fr, n0 + wc * 64 + fq * 8, acc[mi]);
  } else {
#pragma unroll
  for (int mi = 0; mi < 4; ++mi)
#pragma unroll
    for (int ni = 0; ni < 4; ++ni) epi(m0 + wr * 64 + mi * 16 + fr, n0 + wc * 64 + ni * 16 + fq * 4, acc[mi][ni]);
  }
}


DI void fetch_tile(const bf16_t* __restrict__ A, int lda, const bf16_t* __restrict__ B, int ldb, int K, int m0, int n0, unsigned* sink) {
  const int tid = get_tid();
  const int lrow = tid >> 3, lchunk = tid & 7;
  const bf16_t* ga = A + (size_t)(m0 + lrow) * lda + lchunk * 8;
  const bf16_t* gb = B + (size_t)(n0 + lrow) * ldb + lchunk * 8;
  u32x4 x = {0u, 0u, 0u, 0u};
  const int nk = K >> 6;
  for (int kt = 0; kt < nk; ++kt) {
#pragma unroll
    for (int i = 0; i < 4; ++i) {
      x |= *(const u32x4*)(ga + (size_t)(32 * i) * lda + kt * 64);
      x |= *(const u32x4*)(gb + (size_t)(32 * i) * ldb + kt * 64);
    }
  }
  if ((x[0] | x[1] | x[2] | x[3]) == 0x12345u) *sink = 1u;
}
DI int swz4(int row) { return (4 - ((row >> 2) & 3)) & 3; }
template <class Epi, bool GLU = false, bool GROUP = false>
DI void gemm256(const bf16_t* __restrict__ A, int lda, const bf16_t* __restrict__ B, int ldb, int K, int m0, int n0, int mlimit,
                char* lds, const Epi& epi) {
  const int tid = get_tid(), lane = tid & 63, wave = tid >> 6, wr = wave >> 1, wc = wave & 1, fr = lane & 15, fq = lane >> 4;
  f32x4 acc[8][4];
#pragma unroll
  for (int i = 0; i < 8; ++i)
#pragma unroll
    for (int j = 0; j < 4; ++j) acc[i][j] = (f32x4){0.f, 0.f, 0.f, 0.f};
  const int lrow = tid >> 2, lchunk = tid & 3;
  const bf16_t* ga = A + (size_t)(m0 + lrow) * lda + lchunk * 8;
  const bf16_t* gb = B + (size_t)(n0 + lrow) * ldb + lchunk * 8;
  const int soff = lrow * 64 + ((lchunk ^ swz4(lrow)) << 4);
  const int coff = (fq ^ swz4(fr)) << 4;
  u32x4 ra0[4], rb0[2], ra1[4], rb1[2];
  const int nk = K >> 5;
#define H_LOAD(RA, RB, kt) { _Pragma("unroll") for (int i = 0; i < 4; ++i) RA[i] = *(const u32x4*)(ga + (size_t)(64 * i) * lda + (kt) * 32); \
    _Pragma("unroll") for (int i = 0; i < 2; ++i) RB[i] = *(const u32x4*)(gb + (size_t)(64 * i) * ldb + (kt) * 32); }
#define H_STORE(RA, RB, buf) { _Pragma("unroll") for (int i = 0; i < 4; ++i) *(u32x4*)(lds + (buf) * 24576 + soff + i * 4096) = RA[i]; \
    _Pragma("unroll") for (int i = 0; i < 2; ++i) *(u32x4*)(lds + (buf) * 24576 + 16384 + soff + i * 4096) = RB[i]; }
#define H_COMPUTE(buf) { bf16x8 bfr[4]; \
    _Pragma("unroll") for (int i = 0; i < 4; ++i) bfr[i] = *(const bf16x8*)(lds + (buf) * 24576 + 16384 + (wc * 64 + i * 16 + fr) * 64 + coff); \
    _Pragma("unroll") for (int hh = 0; hh < 2; ++hh) { bf16x8 af[4]; \
      _Pragma("unroll") for (int i = 0; i < 4; ++i) af[i] = *(const bf16x8*)(lds + (buf) * 24576 + (wr * 128 + (hh * 4 + i) * 16 + fr) * 64 + coff); \
      _Pragma("unroll") for (int mi = 0; mi < 4; ++mi) _Pragma("unroll") for (int ni = 0; ni < 4; ++ni) acc[hh * 4 + mi][ni] = MFMA16(bfr[ni], af[mi], acc[hh * 4 + mi][ni]); } }
#define H_SCHED do { \
    __builtin_amdgcn_sched_group_barrier(0x100, 8, 0); \
    _Pragma("unroll") for (int g_ = 0; g_ < 4; ++g_) { \
      __builtin_amdgcn_sched_group_barrier(0x008, 4, 0); \
      __builtin_amdgcn_sched_group_barrier(0x020, 1, 0); \
      __builtin_amdgcn_sched_group_barrier(0x100, 1, 0); } \
    _Pragma("unroll") for (int g_ = 0; g_ < 2; ++g_) { \
      __builtin_amdgcn_sched_group_barrier(0x008, 4, 0); \
      __builtin_amdgcn_sched_group_barrier(0x020, 1, 0); } \
    __builtin_amdgcn_sched_group_barrier(0x008, 8, 0); \
    __builtin_amdgcn_sched_barrier(0); } while (0)
  H_LOAD(ra0, rb0, 0);
  H_LOAD(ra1, rb1, 1);
  H_STORE(ra0, rb0, 0);
  __syncthreads();
#pragma unroll 1
  for (int kt = 0; kt < nk; kt += 2) {
    { const int k2 = (kt + 2 < nk) ? kt + 2 : nk - 1; H_LOAD(ra0, rb0, k2); }
    H_COMPUTE(0);
    H_SCHED;
    H_STORE(ra1, rb1, 1);
    __syncthreads();
    { const int k3 = (kt + 3 < nk) ? kt + 3 : nk - 1; H_LOAD(ra1, rb1, k3); }
    H_COMPUTE(1);
    H_SCHED;
    H_STORE(ra0, rb0, 0);
    __syncthreads();
  }
#undef H_LOAD
#undef H_STORE
#undef H_COMPUTE
#undef H_SCHED
  if constexpr (GLU) { epi.glu(acc, m0 + wr * 128, (n0 >> 6) + wc, fr, fq); }
  else {
#pragma unroll
    for (int mi = 0; mi < 8; ++mi) {
      const int row = m0 + wr * 128 + mi * 16 + fr;
      if (row < mlimit) {
        if constexpr (GROUP) epi.group4(row, n0 + wc * 64 + fq * 4, acc[mi]);
        else {
#pragma unroll
          for (int ni = 0; ni < 4; ++ni) epi(row, n0 + wc * 64 + ni * 16 + fq * 4, acc[mi][ni]);
        }
      }
    }
  }
}

DI bool tile_next(int k, int MTt, int NTt, int& mt, int& nt) {
  const int G = gridDim.x, b = blockIdx.x, per = G >> 3;
  const int L = k * G + (b & 7) * per + (b >> 3);
  if (L >= MTt * NTt) return false;
  const int nig = 8 * NTt, gid = L / nig, fm = gid * 8, rem = MTt - fm, gsz = rem < 8 ? rem : 8, w = L - gid * nig;
  mt = fm + (w % gsz); nt = w / gsz;
  return true;
}
template <class Epi, bool GLU = false, bool GROUP = false, bool PERM = false>
DI void gemm256_stream(const bf16_t* __restrict__ A, int lda, const bf16_t* __restrict__ B, int ldb, int K, int MTt, int NTt, int mlimit,
                       char* lds, const Epi& epi) {
  const int tid = get_tid(), lane = tid & 63, wave = tid >> 6, wr = wave >> 1, wc = wave & 1, fr = lane & 15, fq = lane >> 4;
  int mt, nt;
  if (!tile_next(0, MTt, NTt, mt, nt)) return;
  const int lrow = tid >> 2, lchunk = tid & 3;
  const bf16_t* ga = A + (size_t)(mt * 256 + lrow) * lda + lchunk * 8;
  const int brow = PERM ? prow32(lrow) : lrow;
  const bf16_t* gb = B + (size_t)(nt * 128 + brow) * ldb + lchunk * 8;
  const int soff = lrow * 64 + ((lchunk ^ swz4(lrow)) << 4);
  const int coff = (fq ^ swz4(fr)) << 4;
  u32x4 ra0[4], rb0[2], ra1[4], rb1[2];
  const int nk = K >> 5;
#define H_LOADP(RA, RB, PA, PB, kt) { _Pragma("unroll") for (int i = 0; i < 4; ++i) RA[i] = *(const u32x4*)((PA) + (size_t)(64 * i) * lda + (kt) * 32); \
    _Pragma("unroll") for (int i = 0; i < 2; ++i) RB[i] = *(const u32x4*)((PB) + (size_t)(64 * i) * ldb + (kt) * 32); }
#define H_STORE(RA, RB, buf) { _Pragma("unroll") for (int i = 0; i < 4; ++i) *(u32x4*)(lds + (buf) * 24576 + soff + i * 4096) = RA[i]; \
    _Pragma("unroll") for (int i = 0; i < 2; ++i) *(u32x4*)(lds + (buf) * 24576 + 16384 + soff + i * 4096) = RB[i]; }
#define H_COMPUTE(buf) { bf16x8 bfr[4]; \
    _Pragma("unroll") for (int i = 0; i < 4; ++i) bfr[i] = *(const bf16x8*)(lds + (buf) * 24576 + 16384 + (wc * 64 + i * 16 + fr) * 64 + coff); \
    _Pragma("unroll") for (int hh = 0; hh < 2; ++hh) { bf16x8 af[4]; \
      _Pragma("unroll") for (int i = 0; i < 4; ++i) af[i] = *(const bf16x8*)(lds + (buf) * 24576 + (wr * 128 + (hh * 4 + i) * 16 + fr) * 64 + coff); \
      _Pragma("unroll") for (int mi = 0; mi < 4; ++mi) _Pragma("unroll") for (int ni = 0; ni < 4; ++ni) acc[hh * 4 + mi][ni] = MFMA16(bfr[ni], af[mi], acc[hh * 4 + mi][ni]); } }
#define H_SCHED do { \
    __builtin_amdgcn_sched_group_barrier(0x100, 8, 0); \
    _Pragma("unroll") for (int g_ = 0; g_ < 4; ++g_) { \
      __builtin_amdgcn_sched_group_barrier(0x008, 4, 0); \
      __builtin_amdgcn_sched_group_barrier(0x020, 1, 0); \
      __builtin_amdgcn_sched_group_barrier(0x100, 1, 0); } \
    _Pragma("unroll") for (int g_ = 0; g_ < 2; ++g_) { \
      __builtin_amdgcn_sched_group_barrier(0x008, 4, 0); \
      __builtin_amdgcn_sched_group_barrier(0x020, 1, 0); } \
    __builtin_amdgcn_sched_group_barrier(0x008, 8, 0); \
    __builtin_amdgcn_sched_barrier(0); } while (0)
  H_LOADP(ra0, rb0, ga, gb, 0);
  H_LOADP(ra1, rb1, ga, gb, 1);
  H_STORE(ra0, rb0, 0);
  __syncthreads();
#pragma unroll 1
  for (int k = 0;; ++k) {
    int nmt, nnt;
    const bool has_next = tile_next(k + 1, MTt, NTt, nmt, nnt);
    const bf16_t* nga = has_next ? A + (size_t)(nmt * 256 + lrow) * lda + lchunk * 8 : ga;
    const bf16_t* ngb = has_next ? B + (size_t)(nnt * 128 + brow) * ldb + lchunk * 8 : gb;
    f32x4 acc[8][4];
#pragma unroll
    for (int i = 0; i < 8; ++i)
#pragma unroll
      for (int j = 0; j < 4; ++j) acc[i][j] = (f32x4){0.f, 0.f, 0.f, 0.f};
#pragma unroll 1
    for (int kt = 0; kt < nk; kt += 2) {
      { const bool cur = kt + 2 < nk; const bf16_t* pa = cur ? ga : nga; const bf16_t* pb = cur ? gb : ngb; const int kk = cur ? kt + 2 : 0; H_LOADP(ra0, rb0, pa, pb, kk); }
      H_COMPUTE(0);
      H_SCHED;
      H_STORE(ra1, rb1, 1);
      __syncthreads();
      { const bool cur = kt + 3 < nk; const bf16_t* pa = cur ? ga : nga; const bf16_t* pb = cur ? gb : ngb; const int kk = cur ? kt + 3 : 1; H_LOADP(ra1, rb1, pa, pb, kk); }
      H_COMPUTE(1);
      H_SCHED;
      H_STORE(ra0, rb0, 0);
      __syncthreads();
    }
    const int m0 = mt * 256, n0 = nt * 128;
    if constexpr (GLU) { if constexpr (PERM) epi.glu_perm(acc, m0 + wr * 128, (n0 >> 6) + wc, fr, fq); else epi.glu(acc, m0 + wr * 128, (n0 >> 6) + wc, fr, fq); }
    else {
#pragma unroll
      for (int mi = 0; mi < 8; ++mi) {
        const int row = m0 + wr * 128 + mi * 16 + fr;
        if (row < mlimit) {
          if constexpr (PERM) epi.perm8(row, n0 + wc * 64 + fq * 8, acc[mi]);
          else if constexpr (GROUP) epi.group4(row, n0 + wc * 64 + fq * 4, acc[mi]);
          else {
#pragma unroll
            for (int ni = 0; ni < 4; ++ni) epi(row, n0 + wc * 64 + ni * 16 + fq * 4, acc[mi][ni]);
          }
        }
      }
    }
    if (!has_next) break;
    mt = nmt; nt = nnt; ga = nga; gb = ngb;
  }
#undef H_LOADP
#undef H_STORE
#undef H_COMPUTE
#undef H_SCHED
}

DI void st_bf8(bf16_t* dst, f32x4 lo, f32x4 hi) { u32x4 w = {pk2(lo[0], lo[1]), pk2(lo[2], lo[3]), pk2(hi[0], hi[1]), pk2(hi[2], hi[3])}; *(u32x4*)dst = w; }
DI void st_bf4(bf16_t* dst, f32x4 v) { u32x2 w = {pk2(v[0], v[1]), pk2(v[2], v[3])}; *(u32x2*)dst = w; }

struct EpiProj {
  P p;
  DI void operator()(int row, int col, f32x4 v) const {
    if (col < 512) {
      st_bf4(p.hq + (size_t)row * 512 + col, v);
    } else if (col < 1024) {
      const int c = col - 512;
      f32x4 lbv = *(const f32x4*)(p.lb + c), o;
#pragma unroll
      for (int j = 0; j < 4; ++j) { float sg = 1.f / (1.f + __expf(-v[j])); o[j] = logf(lbv[j] + (1.f - lbv[j]) * sg); }
      *(f32x4*)(p.logf + (size_t)row * 512 + c) = o;
    } else if (col < 1536) {
      st_bf4(p.hv + (size_t)row * 512 + (col - 1024), v);
    } else if (col < 2048) {
      f32x4 o;
#pragma unroll
      for (int j = 0; j < 4; ++j) o[j] = v[j] / (1.f + __expf(-v[j]));
      st_bf4(p.hgs + (size_t)row * 512 + (col - 1536), o);
    } else if (col < 2752) {
      st_bf4(p.mla_raw + (size_t)row * 704 + (col - 2048), v);
    }
  }
  DI void perm8(int row, int cb, const f32x4 (&v)[4]) const {
    if (cb < 512) {
#pragma unroll
      for (int q = 0; q < 2; ++q) st_bf8(p.hq + (size_t)row * 512 + cb + q * 32, v[2 * q], v[2 * q + 1]);
    } else if (cb < 1024) {
      const int c = cb - 512;
      f32x4 lbv[4], o[4];
#pragma unroll
      for (int q = 0; q < 2; ++q) { lbv[2 * q] = *(const f32x4*)(p.lb + c + q * 32); lbv[2 * q + 1] = *(const f32x4*)(p.lb + c + q * 32 + 4); }
#pragma unroll
      for (int ni = 0; ni < 4; ++ni)
#pragma unroll
        for (int j = 0; j < 4; ++j) { float sg = 1.f / (1.f + __expf(-v[ni][j])); o[ni][j] = __logf(lbv[ni][j] + (1.f - lbv[ni][j]) * sg); }
#pragma unroll
      for (int q = 0; q < 2; ++q) { float* d = p.logf + (size_t)row * 512 + c + q * 32; *(f32x4*)d = o[2 * q]; *(f32x4*)(d + 4) = o[2 * q + 1]; }
    } else if (cb < 1536) {
#pragma unroll
      for (int q = 0; q < 2; ++q) st_bf8(p.hv + (size_t)row * 512 + (cb - 1024) + q * 32, v[2 * q], v[2 * q + 1]);
    } else if (cb < 2048) {
      f32x4 o[4];
#pragma unroll
      for (int ni = 0; ni < 4; ++ni)
#pragma unroll
        for (int j = 0; j < 4; ++j) o[ni][j] = v[ni][j] / (1.f + __expf(-v[ni][j]));
#pragma unroll
      for (int q = 0; q < 2; ++q) st_bf8(p.hgs + (size_t)row * 512 + (cb - 1536) + q * 32, o[2 * q], o[2 * q + 1]);
    } else if (cb < 2752) {
#pragma unroll
      for (int q = 0; q < 2; ++q) st_bf8(p.mla_raw + (size_t)row * 704 + (cb - 2048) + q * 32, v[2 * q], v[2 * q + 1]);
    }
  }
  DI void group4(int row, int col, const f32x4 (&v)[4]) const {
    if (col >= 512 && col < 1024) {
      const int c = col - 512;
      f32x4 lbv[4], o[4];
#pragma unroll
      for (int ni = 0; ni < 4; ++ni) lbv[ni] = *(const f32x4*)(p.lb + c + ni * 16);
#pragma unroll
      for (int ni = 0; ni < 4; ++ni)
#pragma unroll
        for (int j = 0; j < 4; ++j) { float sg = 1.f / (1.f + __expf(-v[ni][j])); o[ni][j] = logf(lbv[ni][j] + (1.f - lbv[ni][j]) * sg); }
#pragma unroll
      for (int ni = 0; ni < 4; ++ni) *(f32x4*)(p.logf + (size_t)row * 512 + c + ni * 16) = o[ni];
    } else {
#pragma unroll
      for (int ni = 0; ni < 4; ++ni) (*this)(row, col + ni * 16, v[ni]);
    }
  }
};
constexpr float QSCALE = 0.07216878364870322f * 1.4426950408889634f;
struct EpiQ {
  P p;
  DI void operator()(int row, int col, f32x4 v) const {
    if (col < 512) {
      const int h = col >> 7, d = col & 127;
      st_bf4(p.Q + (size_t)row * 768 + h * 192 + d, v * QSCALE);
    } else {
      const int c = col - 512, h = c >> 6, i = (c & 63) >> 1;
      const float* cs = p.rope + ((size_t)row_pos(row) * 32 + i) * 2;
      f32x4 t = *(const f32x4*)cs, o;
      o[0] = v[0] * t[0] - v[1] * t[1]; o[1] = v[1] * t[0] + v[0] * t[1];
      o[2] = v[2] * t[2] - v[3] * t[3]; o[3] = v[3] * t[2] + v[2] * t[3];
      st_bf4(p.Q + (size_t)row * 768 + h * 192 + 128 + (c & 63), o * QSCALE);
    }
  }
  DI void perm8(int row, int cb, const f32x4 (&v)[4]) const {
    if (cb < 512) {
      const int h = cb >> 7, d = cb & 127;
#pragma unroll
      for (int q = 0; q < 2; ++q) st_bf8(p.Q + (size_t)row * 768 + h * 192 + d + q * 32, v[2 * q] * QSCALE, v[2 * q + 1] * QSCALE);
    } else {
      const int c = cb - 512, h = c >> 6, w = c & 63;
      const float* cs = p.rope + ((size_t)row_pos(row) * 32 + (w >> 1)) * 2;
      f32x4 t[4];
#pragma unroll
      for (int q = 0; q < 2; ++q) { t[2 * q] = *(const f32x4*)(cs + q * 32); t[2 * q + 1] = *(const f32x4*)(cs + q * 32 + 4); }
#pragma unroll
      for (int q = 0; q < 2; ++q) {
        f32x4 o[2];
#pragma unroll
        for (int u = 0; u < 2; ++u) {
          const f32x4 x = v[2 * q + u], tt = t[2 * q + u];
          o[u][0] = x[0] * tt[0] - x[1] * tt[1]; o[u][1] = x[1] * tt[0] + x[0] * tt[1];
          o[u][2] = x[2] * tt[2] - x[3] * tt[3]; o[u][3] = x[3] * tt[2] + x[2] * tt[3];
        }
        st_bf8(p.Q + (size_t)row * 768 + h * 192 + 128 + w + q * 32, o[0] * QSCALE, o[1] * QSCALE);
      }
    }
  }
};
struct EpiDry { P p; bool on; DI void operator()(int row, int col, f32x4 v) const { if (on) st_bf4(p.abuf + (size_t)row * 2816 + (col % 2816), v); } };
struct EpiKn { P p; DI void operator()(int row, int col, f32x4 v) const { st_bf4(p.Knope + (size_t)row * 512 + col, v); }
  DI void perm8(int row, int cb, const f32x4 (&v)[4]) const {
#pragma unroll
    for (int q = 0; q < 2; ++q) st_bf8(p.Knope + (size_t)row * 512 + cb + q * 32, v[2 * q], v[2 * q + 1]); } };
struct EpiVt { P p; DI void operator()(int row, int col, f32x4 v) const { st_bf4(p.Vt + (size_t)row * TK + col, v); }
  DI void perm8(int row, int cb, const f32x4 (&v)[4]) const {
#pragma unroll
    for (int q = 0; q < 2; ++q) st_bf8(p.Vt + (size_t)row * TK + cb + q * 32, v[2 * q], v[2 * q + 1]); } };
struct EpiOut {
  P p;
  DI void operator()(int row, int col, f32x4 v) const {
    const float* xr = row < TP ? p.x_p + (size_t)row * 1024 : p.x_s + (size_t)(row - TP) * 1024;
    f32x4 x = *(const f32x4*)(xr + col), g = *(const f32x4*)(p.mod + row_bidx(row) * 6144 + 2048 + col);
    st_bf4(p.x1b + (size_t)row * 1024 + col, x + g * v);
  }
  DI void perm8(int row, int cb, const f32x4 (&v)[4]) const {
    const float* xr = (row < TP ? p.x_p + (size_t)row * 1024 : p.x_s + (size_t)(row - TP) * 1024) + cb;
    const float* gr = p.mod + row_bidx(row) * 6144 + 2048 + cb;
    f32x4 x[4], g[4];
#pragma unroll
    for (int q = 0; q < 2; ++q) { x[2 * q] = *(const f32x4*)(xr + q * 32); x[2 * q + 1] = *(const f32x4*)(xr + q * 32 + 4); g[2 * q] = *(const f32x4*)(gr + q * 32); g[2 * q + 1] = *(const f32x4*)(gr + q * 32 + 4); }
#pragma unroll
    for (int q = 0; q < 2; ++q) st_bf8(p.x1b + (size_t)row * 1024 + cb + q * 32, x[2 * q] + g[2 * q] * v[2 * q], x[2 * q + 1] + g[2 * q + 1] * v[2 * q + 1]);
  }
};
DI float gelu_erf(float v) {
  const float av = fabsf(v), t = __builtin_amdgcn_rcpf(av * 0.2316418882f + 1.0f);
  float q = t * 0.5307027145f + (-0.7265760135f); q = q * t + 0.7107068705f; q = q * t + (-0.142248368f); q = q * t + 0.127414796f; q = q * t;
  const float e = __builtin_amdgcn_exp2f(v * v * (-0.72134752044f));
  const float m = v * (q * e);
  return v < 0.f ? m : v - m;
}
DI float dpp_ror1(float x) { return __int_as_float(__builtin_amdgcn_update_dpp(0, __float_as_int(x), 0x121, 0xf, 0xf, false)); }
DI float dpp_ror2(float x) { return __int_as_float(__builtin_amdgcn_update_dpp(0, __float_as_int(x), 0x122, 0xf, 0xf, false)); }
struct EpiGlu {
  P p;
  DI void glu_perm(const f32x4 (&acc)[8][4], int rbase, int blk32, int fr, int fq) const {
    if (rbase >= T) return;
    const bool sample = rbase >= TP;
    const int f0 = blk32 * 32 + fq * 8;
    f32x4 w0[2], w1[2], w2[2], cb[2];
#pragma unroll
    for (int ni = 0; ni < 2; ++ni) {
      w0[ni] = *(const f32x4*)(p.conv_w + f0 + ni * 4); w1[ni] = *(const f32x4*)(p.conv_w + 2816 + f0 + ni * 4);
      w2[ni] = *(const f32x4*)(p.conv_w + 5632 + f0 + ni * 4); cb[ni] = *(const f32x4*)(p.conv_b + f0 + ni * 4);
    }
#pragma unroll
    for (int mi = 0; mi < 8; ++mi) {
      const int row = rbase + mi * 16 + fr;
      f32x4 g[2];
#pragma unroll
      for (int ni = 0; ni < 2; ++ni)
#pragma unroll
        for (int j = 0; j < 4; ++j) {
          const float a = acc[mi][ni][j];
          const float s1 = dpp_ror1(a), s2 = dpp_ror2(a);
          const float q1 = ((mi & 3) > 0) ? dpp_ror1(acc[mi > 0 ? mi - 1 : 0][ni][j]) : 0.f, q2 = ((mi & 3) > 0) ? dpp_ror2(acc[mi > 0 ? mi - 1 : 0][ni][j]) : 0.f;
          const float a1 = fr >= 1 ? s1 : q1, a2 = fr >= 2 ? s2 : q2;
          const float cv = cb[ni][j] + w0[ni][j] * a2 + w1[ni][j] * a1 + w2[ni][j] * a;
          g[ni][j] = gelu_erf(cv) * acc[mi][ni + 2][j];
        }
      if (sample) {
        st_bf8(p.sA + (size_t)(row - TP) * 2816 + f0, acc[mi][0], acc[mi][1]);
        st_bf8(p.sV + (size_t)(row - TP) * 2816 + f0, acc[mi][2], acc[mi][3]);
        const int pos = (row - TP) & 15;
        if (pos >= 14) { float* d = p.out + O_CVS + ((size_t)((row - TP) >> 4) * 2 + (pos - 14)) * 2816 + f0; *(f32x4*)d = acc[mi][0]; *(f32x4*)(d + 4) = acc[mi][1]; }
      } else {
        const int i64 = (mi & 3) * 16 + fr;
        if (i64 < 2) {
          st_bf8(p.headA + ((size_t)(row >> 6) * 2 + i64) * 2816 + f0, acc[mi][0], acc[mi][1]);
          st_bf8(p.headV + ((size_t)(row >> 6) * 2 + i64) * 2816 + f0, acc[mi][2], acc[mi][3]);
        } else {
          st_bf8(p.vbuf + (size_t)row * 2816 + f0, g[0], g[1]);
          if (i64 >= 62) {
            st_bf8(p.tailA + ((size_t)(row >> 6) * 2 + (i64 - 62)) * 2816 + f0, acc[mi][0], acc[mi][1]);
            const int pos = row & 4095;
            if (pos >= 4094) { float* d = p.out + O_CVP + ((size_t)(row >> 12) * 2 + (pos - 4094)) * 2816 + f0; *(f32x4*)d = acc[mi][0]; *(f32x4*)(d + 4) = acc[mi][1]; }
          }
        }
      }
    }
  }
  DI void glu(const f32x4 (&acc)[8][4], int rbase, int blk32, int fr, int fq) const {
    if (rbase >= T) return;
    const bool sample = rbase >= TP;
#pragma unroll
    for (int ni = 0; ni < 2; ++ni) {
      const int f = blk32 * 32 + ni * 16 + fq * 4;
      const f32x4 w0 = *(const f32x4*)(p.conv_w + f), w1 = *(const f32x4*)(p.conv_w + 2816 + f), w2 = *(const f32x4*)(p.conv_w + 5632 + f), cb = *(const f32x4*)(p.conv_b + f);
#pragma unroll
      for (int mi = 0; mi < 8; ++mi) {
        const int row = rbase + mi * 16 + fr;
        const f32x4 a = acc[mi][ni], v = acc[mi][ni + 2];
        f32x4 g;
#pragma unroll
        for (int j = 0; j < 4; ++j) {
          const float s1 = dpp_ror1(a[j]), s2 = dpp_ror2(a[j]);
          const float q1 = ((mi & 3) > 0) ? dpp_ror1(acc[mi > 0 ? mi - 1 : 0][ni][j]) : 0.f, q2 = ((mi & 3) > 0) ? dpp_ror2(acc[mi > 0 ? mi - 1 : 0][ni][j]) : 0.f;
          const float a1 = fr >= 1 ? s1 : q1, a2 = fr >= 2 ? s2 : q2;
          const float cv = cb[j] + w0[j] * a2 + w1[j] * a1 + w2[j] * a[j];
          g[j] = gelu_erf(cv) * v[j];
        }
        if (sample) {
          st_bf4(p.sA + (size_t)(row - TP) * 2816 + f, a);
          st_bf4(p.sV + (size_t)(row - TP) * 2816 + f, v);
          const int pos = (row - TP) & 15;
          if (pos >= 14) *(f32x4*)(p.out + O_CVS + ((size_t)((row - TP) >> 4) * 2 + (pos - 14)) * 2816 + f) = a;
        } else {
          const int i64 = (mi & 3) * 16 + fr;
          if (i64 < 2) {
            st_bf4(p.headA + ((size_t)(row >> 6) * 2 + i64) * 2816 + f, a);
            st_bf4(p.headV + ((size_t)(row >> 6) * 2 + i64) * 2816 + f, v);
          } else {
            st_bf4(p.vbuf + (size_t)row * 2816 + f, g);
            if (i64 >= 62) {
              st_bf4(p.tailA + ((size_t)(row >> 6) * 2 + (i64 - 62)) * 2816 + f, a);
              const int pos = row & 4095;
              if (pos >= 4094) *(f32x4*)(p.out + O_CVP + ((size_t)(row >> 12) * 2 + (pos - 4094)) * 2816 + f) = a;
            }
          }
        }
      }
    }
  }
};
struct EpiDown {
  P p; bool dry;
  DI void operator()(int row, int col, f32x4 v) const {
    const u32x2 xb = *(const u32x2*)(p.x1b + (size_t)row * 1024 + col);
    const f32x4 x = {bflo(xb[0]), bfhi(xb[0]), bflo(xb[1]), bfhi(xb[1])}, g = *(const f32x4*)(p.mod + row_bidx(row) * 6144 + 5120 + col);
    if (!dry) st_bf4(p.hbuf + (size_t)row * 1024 + col, x + g * v);
  }
  DI void perm8(int row, int cb, const f32x4 (&v)[4]) const {
    const float* gr = p.mod + row_bidx(row) * 6144 + 5120 + cb;
    u32x4 xb[2]; f32x4 g[4];
#pragma unroll
    for (int q = 0; q < 2; ++q) { xb[q] = *(const u32x4*)(p.x1b + (size_t)row * 1024 + cb + q * 32); g[2 * q] = *(const f32x4*)(gr + q * 32); g[2 * q + 1] = *(const f32x4*)(gr + q * 32 + 4); }
#pragma unroll
    for (int q = 0; q < 2; ++q) {
      const f32x4 xlo = {bflo(xb[q][0]), bfhi(xb[q][0]), bflo(xb[q][1]), bfhi(xb[q][1])}, xhi = {bflo(xb[q][2]), bfhi(xb[q][2]), bflo(xb[q][3]), bfhi(xb[q][3])};
      if (!dry) st_bf8(p.hbuf + (size_t)row * 1024 + cb + q * 32, xlo + g[2 * q] * v[2 * q], xhi + g[2 * q + 1] * v[2 * q + 1]);
    }
  }
};

DI int uq_dest(int n) { const int h = n / 192, d = n - h * 192; if (d < 128) return h * 128 + d; const int r = d - 128; return 512 + h * 64 + 2 * (r & 31) + (r >> 5); }
DI int up_dest(int n) { return n < 2816 ? (n >> 5) * 64 + (n & 31) : ((n - 2816) >> 5) * 64 + 32 + ((n - 2816) & 31); }
DI void transpose_tile(const float* __restrict__ W, int K, int N, bf16_t* __restrict__ Wt, int k0, int n0, int mode, char* lds) {
  float* s = (float*)lds;
  const int tid = get_tid();
  __syncthreads();
#pragma unroll
  for (int r = 0; r < 16; ++r) {
    const int i = (tid >> 6) + 4 * r, j = tid & 63, n = n0 + j;
    s[i * 65 + j] = (n < N) ? W[(size_t)(k0 + i) * N + n] : 0.f;
  }
  __syncthreads();
#pragma unroll
  for (int r = 0; r < 16; ++r) {
    const int i = tid & 63, j = (tid >> 6) + 4 * r, n = n0 + j;
    const int dn = (mode == 1) ? uq_dest(n) : (mode == 2) ? up_dest(n) : n;
    Wt[(size_t)dn * K + k0 + i] = f2bf(s[i * 65 + j]);
  }
}
DI void mod_item(const P& p, int item, char* lds) {
  float* sc = (float*)lds;
  const int tid = get_tid();
  __syncthreads();
  for (int e = tid; e < 16384; e += 256) {
    const int r = e >> 10, k = e & 1023;
    const float c = (r < 8) ? p.c_p[r * 1024 + k] : p.c_s[(r - 8) * 1024 + k];
    sc[e] = c / (1.f + __expf(-c));
  }
  __syncthreads();
  const int col = item * 32 + (tid & 31), kg = tid >> 5;
  float acc[16];
#pragma unroll
  for (int r = 0; r < 16; ++r) acc[r] = 0.f;
  for (int k0 = kg * 128; k0 < kg * 128 + 128; k0 += 16) {
    float w[16];
#pragma unroll
    for (int u = 0; u < 16; ++u) w[u] = p.w_ada[(size_t)(k0 + u) * 6144 + col];
#pragma unroll
    for (int u = 0; u < 16; ++u)
#pragma unroll
      for (int r = 0; r < 16; ++r) acc[r] += sc[r * 1024 + k0 + u] * w[u];
  }
  __syncthreads();
#pragma unroll
  for (int r = 0; r < 16; ++r) sc[(kg * 16 + r) * 32 + (tid & 31)] = acc[r];
  __syncthreads();
  for (int e = tid; e < 512; e += 256) {
    const int r = e >> 5, c = e & 31;
    float s = p.b_ada[item * 32 + c];
#pragma unroll
    for (int g = 0; g < 8; ++g) s += sc[(g * 16 + r) * 32 + c];
    p.mod[r * 6144 + item * 32 + c] = s;
  }
}
DI void rope_item(const P& p, int item) {
  const int e = item * 256 + get_tid();
  if (e >= 4112 * 32) return;
  const int pos = e >> 5, i = e & 31;
  double f = 1.0;
  for (int q = 0; q < i; ++q) f *= 0.7498942093324559;
  double ang = (double)pos * f;
  const double TWO_PI = 6.283185307179586476925;
  double n = __builtin_rint(ang / TWO_PI);
  double r = ang - n * TWO_PI;
  double r2 = r * r;
  double s = 0.0, c = 0.0;
  double ts = r, tc = 1.0;
  s = ts; c = tc;
#pragma unroll 1
  for (int q = 1; q <= 14; ++q) {
    tc = -tc * r2 / (double)((2 * q - 1) * (2 * q));
    ts = -ts * r2 / (double)((2 * q) * (2 * q + 1));
    c += tc; s += ts;
  }
  p.rope[(size_t)e * 2] = (float)c;
  p.rope[(size_t)e * 2 + 1] = (float)s;
}
DI void cache_item(const P& p, int item) {
  const int tid = get_tid();
  const size_t r0 = (size_t)item * 64;
  f32x4 v[16]; float k0[8], k1[8];
#pragma unroll
  for (int i = 0; i < 16; ++i) v[i] = *(const f32x4*)(p.cache_lat + r0 * 256 + (size_t)(tid + 256 * i) * 4);
#pragma unroll
  for (int i = 0; i < 8; ++i) {
    const int e = tid + 256 * i, row = e >> 5, q = e & 31;
    const float* src = p.cache_kpe + (r0 + row) * 64;
    k0[i] = src[q]; k1[i] = src[32 + q];
  }
#pragma unroll
  for (int i = 0; i < 16; ++i) st_bf4(p.lat_all + ((size_t)T + r0) * 256 + (size_t)(tid + 256 * i) * 4, v[i]);
#pragma unroll
  for (int i = 0; i < 8; ++i) {
    const int e = tid + 256 * i, row = e >> 5, q = e & 31;
    *(unsigned*)(p.kpe_all + ((size_t)T + r0 + row) * 64 + 2 * q) = pk2(k0[i], k1[i]);
  }
}
constexpr int NT_IN = 16 * 44, NT_UQ = 6 * 12, NT_UK = 4 * 8, NT_OUT = 16 * 16, NT_UP = 16 * 88, NT_DN = 44 * 16;
constexpr int P0_TR = NT_IN + NT_UQ + 2 * NT_UK + NT_OUT + NT_UP + NT_DN;
constexpr int P0_MOD = 192, P0_ROPE = 514, P0_CACHE = 512;
constexpr int P0_TOTAL = P0_TR + P0_MOD + P0_ROPE + P0_CACHE + 1, P0_EARLY = P0_MOD + NT_IN;
DI void p0_item(const P& p, int it, char* lds) {
  {
    int i = it;
    if (i < P0_MOD) { mod_item(p, i, lds); return; }
    i -= P0_MOD;
    if (i < P0_TR) {
      if (i < NT_IN) { transpose_tile(p.w_in, 1024, 2752, p.WinT, (i / 44) * 64, (i % 44) * 64, 0, lds); return; }
      i -= NT_IN;
      if (i < NT_UQ) { transpose_tile(p.w_uq, 384, 768, p.WuqT, (i / 12) * 64, (i % 12) * 64, 1, lds); return; }
      i -= NT_UQ;
      if (i < NT_UK) { transpose_tile(p.w_uk, 256, 512, p.WukT, (i / 8) * 64, (i % 8) * 64, 0, lds); return; }
      i -= NT_UK;
      if (i < NT_UK) { transpose_tile(p.w_uv, 256, 512, p.WuvT, (i / 8) * 64, (i % 8) * 64, 0, lds); return; }
      i -= NT_UK;
      if (i < NT_OUT) { transpose_tile(p.w_out, 1024, 1024, p.WoutT, (i / 16) * 64, (i % 16) * 64, 0, lds); return; }
      i -= NT_OUT;
      if (i < NT_UP) { transpose_tile(p.w_up, 1024, 5632, p.WupT, (i / 88) * 64, (i % 88) * 64, 2, lds); return; }
      i -= NT_UP;
      transpose_tile(p.w_down, 2816, 1024, p.WdownT, (i / 16) * 64, (i % 16) * 64, 0, lds);
      return;
    }
    i -= P0_TR;
    if (i < P0_ROPE) { rope_item(p, i); return; }
    i -= P0_ROPE;
    if (i < P0_CACHE) { cache_item(p, i); return; }
    for (int c = get_tid(); c < 512; c += 256) p.lb[c] = 1.f / (1.f + __expf(p.lb_logits[512 + c] - p.lb_logits[c]));
  }
}
DI void phase0(const P& p, char* lds) {
  for (int it = blockIdx.x; it < P0_EARLY + 1; it += gridDim.x) p0_item(p, it < P0_EARLY ? it : P0_TOTAL - 1, lds);
}

constexpr int RPW = 4;
DI void rownorm_phase(const P& p, int which) {
  const int lane = get_tid() & 63, gw = blockIdx.x * 4 + (get_tid() >> 6), nw = gridDim.x * 4;
  const float* gain = which ? p.g_ffn : p.g_mix;
  for (int row0 = gw * RPW; row0 < T; row0 += nw * RPW) {
    f32x4 v[RPW][4];
    float ss[RPW]; for (int r = 0; r < RPW; ++r) ss[r] = 0.f;
#pragma unroll
    for (int r = 0; r < RPW; ++r) {
      const int row = row0 + r;
      const float* src = row < TP ? p.x_p + (size_t)row * 1024 : p.x_s + (size_t)(row - TP) * 1024;
#pragma unroll
      for (int h = 0; h < 2; ++h) {
        const int c = lane * 8 + 512 * h;
        if (which) { const u32x4 xb = *(const u32x4*)(p.x1b + (size_t)row * 1024 + c);
          v[r][2 * h] = (f32x4){bflo(xb[0]), bfhi(xb[0]), bflo(xb[1]), bfhi(xb[1])}; v[r][2 * h + 1] = (f32x4){bflo(xb[2]), bfhi(xb[2]), bflo(xb[3]), bfhi(xb[3])}; }
        else { v[r][2 * h] = *(const f32x4*)(src + c); v[r][2 * h + 1] = *(const f32x4*)(src + c + 4); }
      }
#pragma unroll
      for (int i = 0; i < 4; ++i) ss[r] += v[r][i][0] * v[r][i][0] + v[r][i][1] * v[r][i][1] + v[r][i][2] * v[r][i][2] + v[r][i][3] * v[r][i][3];
    }
    f32x4 o[RPW][4];
#pragma unroll
    for (int r = 0; r < RPW; ++r) {
      const int row = row0 + r;
      const float rstd = rsqrtf(wave_sum(ss[r]) * (1.f / 1024.f) + EPS);
      const float* m = p.mod + row_bidx(row) * 6144 + (which ? 3072 : 0);
#pragma unroll
      for (int i = 0; i < 4; ++i) {
        const int c = lane * 8 + 512 * (i >> 1) + 4 * (i & 1);
        f32x4 g = *(const f32x4*)(gain + c), sh = *(const f32x4*)(m + c), sc = *(const f32x4*)(m + 1024 + c);
        o[r][i] = v[r][i] * rstd * g * (sc + 1.f) + sh;
      }
    }
#pragma unroll
    for (int r = 0; r < RPW; ++r)
#pragma unroll
      for (int h = 0; h < 2; ++h) st_bf8(p.hbuf + (size_t)(row0 + r) * 1024 + lane * 8 + 512 * h, o[r][2 * h], o[r][2 * h + 1]);
  }
}
DI void final_phase(const P& p, bool dry) {
  const int lane = get_tid() & 63, gw = blockIdx.x * 4 + (get_tid() >> 6), nw = gridDim.x * 4;
  for (int row0 = gw * RPW; row0 < T; row0 += nw * RPW) {
    f32x4 v[RPW][4];
    float ss[RPW]; for (int r = 0; r < RPW; ++r) ss[r] = 0.f;
#pragma unroll
    for (int r = 0; r < RPW; ++r) {
      const bf16_t* src = p.hbuf + (size_t)(row0 + r) * 1024;
#pragma unroll
      for (int h = 0; h < 2; ++h) { const u32x4 xb = *(const u32x4*)(src + lane * 8 + 512 * h);
        v[r][2 * h] = (f32x4){bflo(xb[0]), bfhi(xb[0]), bflo(xb[1]), bfhi(xb[1])}; v[r][2 * h + 1] = (f32x4){bflo(xb[2]), bfhi(xb[2]), bflo(xb[3]), bfhi(xb[3])}; }
#pragma unroll
      for (int i = 0; i < 4; ++i) ss[r] += v[r][i][0] * v[r][i][0] + v[r][i][1] * v[r][i][1] + v[r][i][2] * v[r][i][2] + v[r][i][3] * v[r][i][3];
    }
    f32x4 gf[4];
#pragma unroll
    for (int i = 0; i < 4; ++i) gf[i] = *(const f32x4*)(p.g_final + lane * 8 + 512 * (i >> 1) + 4 * (i & 1));
#pragma unroll
    for (int r = 0; r < RPW; ++r) {
      float* dst = p.out + O_Y + (size_t)(row0 + r) * 1024;
      const float rstd = rsqrtf(wave_sum(ss[r]) * (1.f / 1024.f) + EPS);
#pragma unroll
      for (int i = 0; i < 4; ++i) { const int c = lane * 8 + 512 * (i >> 1) + 4 * (i & 1); if (!dry) *(f32x4*)(dst + c) = v[r][i] * rstd * gf[i]; }
    }
  }
}
DI void post_row(const P& p, int row, int lane) {
  const bf16_t* raw = p.mla_raw + (size_t)row * 704;
  const int i = lane & 31;
  float q[6];
#pragma unroll
  for (int j = 0; j < 6; ++j) q[j] = bf2f(raw[lane + 64 * j]);
  const u32x2 kvb = *(const u32x2*)(raw + 384 + lane * 4);
  const f32x4 kv = {bflo(kvb[0]), bfhi(kvb[0]), bflo(kvb[1]), bfhi(kvb[1])};
  const float x = bf2f(raw[640 + lane]);
  const float* cs = p.rope + ((size_t)row_pos(row) * 32 + i) * 2;
  const float c = cs[0], s = cs[1];
  float qg[6];
#pragma unroll
  for (int j = 0; j < 6; ++j) qg[j] = p.qn_g[lane + 64 * j];
  const f32x4 kg = *(const f32x4*)(p.kvn_g + lane * 4);
  float ss = 0.f;
#pragma unroll
  for (int j = 0; j < 6; ++j) ss += q[j] * q[j];
  ss = wave_sum(ss);
  float ss2 = wave_sum(kv[0] * kv[0] + kv[1] * kv[1] + kv[2] * kv[2] + kv[3] * kv[3]);
  const float xo = __shfl_xor(x, 32);
  float rstd = rsqrtf(ss * (1.f / 384.f) + EPS);
#pragma unroll
  for (int j = 0; j < 6; ++j) p.cqn[(size_t)row * 384 + lane + 64 * j] = f2bf(q[j] * rstd * qg[j]);
  rstd = rsqrtf(ss2 * (1.f / 256.f) + EPS);
  f32x4 lat = kv * rstd * kg;
  float* lo = row < TP ? p.out + O_LATP + (size_t)row * 256 : p.out + O_LATS + (size_t)(row - TP) * 256;
  *(f32x4*)(lo + lane * 4) = lat;
  st_bf4(p.lat_all + (size_t)row * 256 + lane * 4, lat);
  const float r = (lane < 32) ? x * c - xo * s : x * c + xo * s;
  float* ko = row < TP ? p.out + O_KRP + (size_t)row * 64 : p.out + O_KRS + (size_t)(row - TP) * 64;
  ko[lane] = r;
  p.kpe_all[(size_t)row * 64 + 2 * i + (lane >> 5)] = f2bf(r);
}

struct HgCtx { int r0, nvalid, h, id; };
DI HgCtx hg_ctx(int id) {
  HgCtx c; c.id = id;
  if (id < 2048) { c.h = id & 3; const int bc = id >> 2; c.r0 = (bc >> 6) * 4096 + (bc & 63) * 64; c.nvalid = 64; }
  else { const int j = id - 2048; c.h = j & 3; c.r0 = TP + (j >> 2) * 16; c.nvalid = 16; }
  return c;
}
DI void hg_load_vt(const P& p, const HgCtx& c, char* ldsVT) {
  const int tid = get_tid(), s = tid & 63;
#pragma unroll
  for (int i = 0; i < 4; ++i) {
    const int chunk = (tid >> 6) + 4 * i;
    u32x4 raw = {0u, 0u, 0u, 0u};
    if (s < c.nvalid) raw = *(const u32x4*)(p.hv + (size_t)(c.r0 + s) * 512 + c.h * 128 + chunk * 8);
    bf16_t* d = (bf16_t*)ldsVT + (chunk * 8) * 72 + s;
    d[0 * 72] = (bf16_t)(raw[0] & 0xffff); d[1 * 72] = (bf16_t)(raw[0] >> 16);
    d[2 * 72] = (bf16_t)(raw[1] & 0xffff); d[3 * 72] = (bf16_t)(raw[1] >> 16);
    d[4 * 72] = (bf16_t)(raw[2] & 0xffff); d[5 * 72] = (bf16_t)(raw[2] >> 16);
    d[6 * 72] = (bf16_t)(raw[3] & 0xffff); d[7 * 72] = (bf16_t)(raw[3] >> 16);
  }
}
DI void hg1_item(const P& p, int id, char* lds) {
  const HgCtx c = hg_ctx(id);
  const int tid = get_tid(), lane = tid & 63, wave = tid >> 6, fr = lane & 15, fq = lane >> 4;
  const int k = tid & 127, half = tid >> 7;
  float* red = (float*)lds;
  char* ldsKT = lds + 1024;
  char* ldsVT = lds + 1024 + 18432;
  __syncthreads();
  float lf[32], bb[32];
  float run = 0.f;
#pragma unroll
  for (int i = 0; i < 32; ++i) {
    const int s = half * 32 + i;
    lf[i] = (s < c.nvalid) ? p.logf[(size_t)(c.r0 + s) * 512 + c.h * 128 + k] : 0.f;
    run += lf[i]; bb[i] = run;
  }
  red[tid] = run;
  hg_load_vt(p, c, ldsVT);
  __syncthreads();
  const float off = half ? red[k] : 0.f, blast = red[k] + red[128 + k];
#pragma unroll
  for (int i = 0; i < 32; i += 2) {
    const float k0 = (1.f - __expf(lf[i])) * __expf(blast - (bb[i] + off));
    const float k1 = (1.f - __expf(lf[i + 1])) * __expf(blast - (bb[i + 1] + off));
    *(unsigned*)(ldsKT + (k * 72 + half * 32 + i) * 2) = pk2(k0, k1);
  }
  if (tid < 128) p.Dbuf[(size_t)id * 128 + k] = __expf(blast);
  __syncthreads();
  f32x4 acc[2][8];
#pragma unroll
  for (int a = 0; a < 2; ++a)
#pragma unroll
    for (int b = 0; b < 8; ++b) acc[a][b] = (f32x4){0.f, 0.f, 0.f, 0.f};
#pragma unroll
  for (int ss = 0; ss < 2; ++ss) {
    bf16x8 ka[2];
#pragma unroll
    for (int a = 0; a < 2; ++a) ka[a] = *(const bf16x8*)(ldsKT + (((wave * 2 + a) * 16 + fr) * 72 + ss * 32 + fq * 8) * 2);
#pragma unroll
    for (int b = 0; b < 8; ++b) {
      const bf16x8 vb = *(const bf16x8*)(ldsVT + ((b * 16 + fr) * 72 + ss * 32 + fq * 8) * 2);
#pragma unroll
      for (int a = 0; a < 2; ++a) acc[a][b] = MFMA16(ka[a], vb, acc[a][b]);
    }
  }
#pragma unroll
  for (int a = 0; a < 2; ++a)
#pragma unroll
    for (int b = 0; b < 8; ++b) st_bf4(p.dS + (size_t)id * 16384 + (b * 16 + fr) * 128 + (wave * 2 + a) * 16 + fq * 4, acc[a][b]);
}
DI void hg2_item(const P& p, int item) {
  const int tid = get_tid();
  if (item < 512) {
    const int sh = item >> 4, b = sh >> 2, h = sh & 3, e = (item & 15) * 1024 + tid * 4, v = e >> 7, k = e & 127;
    float S[4] = {0.f, 0.f, 0.f, 0.f};
    for (int c0 = 0; c0 < 64; c0 += 8) {
      u32x2 raw[8]; f32x4 dv[8];
#pragma unroll
      for (int j = 0; j < 8; ++j) {
        const size_t id = (size_t)((b * 64 + c0 + j) * 4 + h);
        raw[j] = *(const u32x2*)(p.dS + id * 16384 + e);
        dv[j] = *(const f32x4*)(p.Dbuf + id * 128 + k);
      }
#pragma unroll
      for (int j = 0; j < 8; ++j) {
        const size_t id = (size_t)((b * 64 + c0 + j) * 4 + h);
        u32x2 w = {pk2(S[0], S[1]), pk2(S[2], S[3])};
        *(u32x2*)(p.dS + id * 16384 + e) = w;
        S[0] = dv[j][0] * S[0] + bflo(raw[j][0]); S[1] = dv[j][1] * S[1] + bfhi(raw[j][0]);
        S[2] = dv[j][2] * S[2] + bflo(raw[j][1]); S[3] = dv[j][3] * S[3] + bfhi(raw[j][1]);
      }
    }
#pragma unroll
    for (int j = 0; j < 4; ++j) p.out[O_HGP + ((size_t)(b * 4 + h) * 128 + k + j) * 128 + v] = S[j];
  } else {
    const int it = item - 512, sh = it >> 4, e = (it & 15) * 1024 + tid * 4, v = e >> 7, k = e & 127;
    const size_t id = 2048 + sh;
    float S[4];
#pragma unroll
    for (int j = 0; j < 4; ++j) S[j] = p.st_hg[((size_t)sh * 128 + k + j) * 128 + v];
    const u32x2 raw = *(const u32x2*)(p.dS + id * 16384 + e);
    const f32x4 dv = *(const f32x4*)(p.Dbuf + id * 128 + k);
    u32x2 w = {pk2(S[0], S[1]), pk2(S[2], S[3])};
    *(u32x2*)(p.dS + id * 16384 + e) = w;
    S[0] = dv[0] * S[0] + bflo(raw[0]); S[1] = dv[1] * S[1] + bfhi(raw[0]);
    S[2] = dv[2] * S[2] + bflo(raw[1]); S[3] = dv[3] * S[3] + bfhi(raw[1]);
#pragma unroll
    for (int j = 0; j < 4; ++j) p.out[O_HGS + ((size_t)sh * 128 + k + j) * 128 + v] = S[j];
  }
}
DI void hg3_item(const P& p, int id, char* lds) {
  const HgCtx c = hg_ctx(id);
  const int tid = get_tid(), lane = tid & 63, wave = tid >> 6, fr = lane & 15, fq = lane >> 4;
  const int k = tid & 127, half = tid >> 7;
  float* red = (float*)lds;
  char* ldsQ = lds + 1024;
  char* ldsK = ldsQ + 64 * 136 * 2;
  char* ldsVT = ldsK + 64 * 136 * 2;
  __syncthreads();
  float lf[32], qr[32];
  float run = 0.f;
#pragma unroll
  for (int i = 0; i < 32; ++i) {
    const int s = half * 32 + i;
    lf[i] = (s < c.nvalid) ? p.logf[(size_t)(c.r0 + s) * 512 + c.h * 128 + k] : 0.f;
    qr[i] = (s < c.nvalid) ? bf2f(p.hq[(size_t)(c.r0 + s) * 512 + c.h * 128 + k]) : 0.f;
  }
  u32x4 sreg[8];
#pragma unroll
  for (int i = 0; i < 8; ++i) sreg[i] = *(const u32x4*)(p.dS + (size_t)id * 16384 + (size_t)(tid + 256 * i) * 8);
#pragma unroll
  for (int i = 0; i < 32; ++i) run += lf[i];
  red[tid] = run;
  hg_load_vt(p, c, ldsVT);
  __syncthreads();
  float bcur = half ? red[k] : 0.f;
#pragma unroll
  for (int i = 0; i < 32; ++i) {
    const int s = half * 32 + i;
    bcur += lf[i];
    const float qv = qr[i];
    ((bf16_t*)ldsQ)[s * 136 + k] = f2bf(qv * 0.08838834764831845f * __expf(bcur));
    ((bf16_t*)ldsK)[s * 136 + k] = f2bf((1.f - __expf(lf[i])) * __expf(-bcur));
  }
  __syncthreads();
  bf16x8 qf[4];
#pragma unroll
  for (int ks = 0; ks < 4; ++ks) qf[ks] = *(const bf16x8*)(ldsQ + ((wave * 16 + fr) * 136 + ks * 32 + fq * 8) * 2);
  f32x4 sc[4];
#pragma unroll
  for (int ssub = 0; ssub < 4; ++ssub) {
    sc[ssub] = (f32x4){0.f, 0.f, 0.f, 0.f};
    if (ssub <= wave) {
#pragma unroll
      for (int ks = 0; ks < 4; ++ks) {
        const bf16x8 kf = *(const bf16x8*)(ldsK + ((ssub * 16 + fr) * 136 + ks * 32 + fq * 8) * 2);
        sc[ssub] = MFMA16(kf, qf[ks], sc[ssub]);
      }
      const int t = wave * 16 + fr;
#pragma unroll
      for (int j = 0; j < 4; ++j) if (ssub * 16 + fq * 4 + j > t) sc[ssub][j] = 0.f;
    }
  }
  bf16x8 pf[2];
#pragma unroll
  for (int kk = 0; kk < 2; ++kk) {
    u32x4 w = {pk2(sc[2 * kk][0], sc[2 * kk][1]), pk2(sc[2 * kk][2], sc[2 * kk][3]), pk2(sc[2 * kk + 1][0], sc[2 * kk + 1][1]), pk2(sc[2 * kk + 1][2], sc[2 * kk + 1][3])};
    pf[kk] = __builtin_bit_cast(bf16x8, w);
  }
  f32x4 o[8];
  float ssq = 0.f;
#pragma unroll
  for (int vs = 0; vs < 8; ++vs) {
    o[vs] = (f32x4){0.f, 0.f, 0.f, 0.f};
#pragma unroll
    for (int kk = 0; kk < 2; ++kk) {
      const char* vp = ldsVT + ((vs * 16 + fr) * 72 + kk * 32 + fq * 4) * 2;
      const u32x2 lo = *(const u32x2*)vp, hi = *(const u32x2*)(vp + 32);
      u32x4 w = {lo[0], lo[1], hi[0], hi[1]};
      o[vs] = MFMA16(__builtin_bit_cast(bf16x8, w), pf[kk], o[vs]);
    }
  }
  __syncthreads();
#pragma unroll
  for (int i = 0; i < 8; ++i) { const int idx = tid + 256 * i; *(u32x4*)(ldsQ + ((idx >> 4) * 136 + (idx & 15) * 8) * 2) = sreg[i]; }
  __syncthreads();
#pragma unroll
  for (int vs = 0; vs < 8; ++vs) {
#pragma unroll
    for (int ks = 0; ks < 4; ++ks) {
      const bf16x8 sf = *(const bf16x8*)(ldsQ + ((vs * 16 + fr) * 136 + ks * 32 + fq * 8) * 2);
      o[vs] = MFMA16(sf, qf[ks], o[vs]);
    }
    ssq += o[vs][0] * o[vs][0] + o[vs][1] * o[vs][1] + o[vs][2] * o[vs][2] + o[vs][3] * o[vs][3];
  }
  ssq += __shfl_xor(ssq, 16); ssq += __shfl_xor(ssq, 32);
  const float rn = rsqrtf(ssq * (1.f / 128.f) + EPS);
  const int t = wave * 16 + fr;
  if (t < c.nvalid) {
    const size_t row = (size_t)(c.r0 + t);
    u32x2 gt[8]; f32x4 gnn[8];
#pragma unroll
    for (int vs = 0; vs < 8; ++vs) { const int v0 = vs * 16 + fq * 4; gt[vs] = *(const u32x2*)(p.hgs + row * 512 + c.h * 128 + v0); gnn[vs] = *(const f32x4*)(p.hg_gain + v0); }
#pragma unroll
    for (int vs = 0; vs < 8; ++vs) {
      const int v0 = vs * 16 + fq * 4;
      const u32x2 g = gt[vs]; const f32x4 gn = gnn[vs];
      f32x4 r = {o[vs][0] * rn * gn[0] * bflo(g[0]), o[vs][1] * rn * gn[1] * bfhi(g[0]), o[vs][2] * rn * gn[2] * bflo(g[1]), o[vs][3] * rn * gn[3] * bfhi(g[1])};
      st_bf4(p.mix + row * 1024 + c.h * 128 + v0, r);
    }
  }
}

DI void attn_item(const P& p, int kind, int b, int h, int qb, char* lds) {
  const int tid = get_tid(), lane = tid & 63, wave = tid >> 6, fr = lane & 15, fq = lane >> 4;
  int qrow0, nsub, nt, my_nt, ntA; size_t baseA, baseB;
  if (kind == 0) { qrow0 = b * 4096 + qb * 128 + wave * 32; nsub = 2; nt = 2 * qb + 2; my_nt = (wave < 2) ? nt - 1 : nt; ntA = nt; baseA = (size_t)b * 4096; baseB = 0; }
  else { qrow0 = TP + b * 16; nsub = (wave == 0) ? 1 : 0; nt = 65; my_nt = (wave == 0) ? 65 : 0; ntA = 64; baseA = (size_t)T + (size_t)b * 4096; baseB = (size_t)TP + b * 16; }
  char* ldsK = lds;
  char* ldsV = lds + 24576;
  bf16x8 qf[2][6];
#pragma unroll
  for (int qs = 0; qs < 2; ++qs)
#pragma unroll
    for (int ks = 0; ks < 6; ++ks) {
      u32x4 z = {0u, 0u, 0u, 0u};
      if (qs < nsub) z = *(const u32x4*)(p.Q + (size_t)(qrow0 + qs * 16 + fr) * 768 + h * 192 + ks * 32 + fq * 8);
      qf[qs][ks] = __builtin_bit_cast(bf16x8, z);
    }
  const char* kb0 = ldsK + fr * 384 + ((fq ^ (fr & 7)) << 4);
  const char* kb1 = ldsK + fr * 384 + (((4 | fq) ^ (fr & 7)) << 4);
  const char* vb0 = ldsV + fr * 136 + fq * 8;
  u32x4 rk[6], rv[4];
  const int nkey = tid >> 4, nc = tid & 15, pkey = tid >> 3, pc = tid & 7, vdv = tid >> 3, vc = tid & 7;
  const bf16_t* gkn = p.Knope + (size_t)nkey * 512 + h * 128 + nc * 8;
  const bf16_t* gkp = p.kpe_all + (size_t)pkey * 64 + pc * 8;
  const bf16_t* gv = p.Vt + (size_t)(h * 128 + vdv) * TK + vc * 8;
  char* skn = ldsK + nkey * 384 + ((nc ^ (nkey & 7)) << 4);
  char* skp = ldsK + pkey * 384 + ((16 + (pc ^ (pkey & 7))) << 4);
  char* sv = ldsV + vdv * 136 + vc * 16;
  auto issue = [&](int t) {
    const size_t krow0 = (t < ntA) ? baseA + (size_t)t * 64 : baseB;
#pragma unroll
    for (int i = 0; i < 4; ++i) rk[i] = *(const u32x4*)(gkn + (krow0 + 16 * i) * 512);
#pragma unroll
    for (int i = 0; i < 2; ++i) rk[4 + i] = *(const u32x4*)(gkp + (krow0 + 32 * i) * 64);
  };
  auto issueV = [&](int t) {
    const size_t krow0 = (t < ntA) ? baseA + (size_t)t * 64 : baseB;
#pragma unroll
    for (int i = 0; i < 4; ++i) rv[i] = *(const u32x4*)(gv + (size_t)(32 * i) * TK + krow0);
  };
  issue(0); issueV(0);
  float m[2] = {-1e30f, -1e30f}, l[2] = {0.f, 0.f};
  f32x4 o[2][8];
#pragma unroll
  for (int qs = 0; qs < 2; ++qs)
#pragma unroll
    for (int d = 0; d < 8; ++d) o[qs][d] = (f32x4){0.f, 0.f, 0.f, 0.f};
  for (int t = 0; t < nt; ++t) {
    __syncthreads();
#pragma unroll
    for (int i = 0; i < 4; ++i) *(u32x4*)(skn + i * 6144) = rk[i];
#pragma unroll
    for (int i = 0; i < 2; ++i) *(u32x4*)(skp + i * 12288) = rk[4 + i];
#pragma unroll
    for (int i = 0; i < 4; ++i) {
      u32x2 a = {rv[i][0], rv[i][1]}, bb = {rv[i][2], rv[i][3]};
      *(u32x2*)(sv + i * 4352) = a;
      *(u32x2*)(sv + i * 4352 + 8) = bb;
    }
    __syncthreads();
    if (t + 1 < nt) issue(t + 1);
    if (t >= my_nt && t + 1 < nt) issueV(t + 1);
    if (t < my_nt) {
      const int nvalid = (t < ntA) ? 64 : 16;
      f32x4 s[2][4];
#pragma unroll
      for (int ksub = 0; ksub < 4; ++ksub) {
        s[0][ksub] = (f32x4){0.f, 0.f, 0.f, 0.f}; s[1][ksub] = s[0][ksub];
        bf16x8 kf[6];
#pragma unroll
        for (int ks = 0; ks < 6; ++ks) kf[ks] = *(const bf16x8*)(((ks & 1) ? kb1 : kb0) + ksub * 6144 + (ks >> 1) * 128);
#pragma unroll
        for (int ks = 0; ks < 6; ++ks) {
          s[0][ksub] = MFMA16(kf[ks], qf[0][ks], s[0][ksub]);
          if (nsub > 1) s[1][ksub] = MFMA16(kf[ks], qf[1][ks], s[1][ksub]);
        }
        __builtin_amdgcn_sched_barrier(0);
      }
      bf16x8 pf[2][2];
#pragma unroll
      for (int qs = 0; qs < 2; ++qs) {
        if (qs < nsub) {
          if (nvalid < 64) {
#pragma unroll
            for (int ksub = 0; ksub < 4; ++ksub)
#pragma unroll
              for (int j = 0; j < 4; ++j) if (ksub * 16 + fq * 4 + j >= nvalid) s[qs][ksub][j] = -1e30f;
          }
          float mx = -1e30f;
#pragma unroll
          for (int ksub = 0; ksub < 4; ++ksub)
#pragma unroll
            for (int j = 0; j < 4; ++j) mx = fmaxf(mx, s[qs][ksub][j]);
          mx = fmaxf(mx, __shfl_xor(mx, 16)); mx = fmaxf(mx, __shfl_xor(mx, 32));
          const float mn = fmaxf(m[qs], mx), alpha = __builtin_amdgcn_exp2f(m[qs] - mn);
          m[qs] = mn;
          float ps = 0.f;
#pragma unroll
          for (int ksub = 0; ksub < 4; ++ksub)
#pragma unroll
            for (int j = 0; j < 4; ++j) { const float e = __builtin_amdgcn_exp2f(s[qs][ksub][j] - mn); s[qs][ksub][j] = e; ps += e; }
          l[qs] = l[qs] * alpha + ps;
#pragma unroll
          for (int d = 0; d < 8; ++d) o[qs][d] = o[qs][d] * alpha;
#pragma unroll
          for (int kk = 0; kk < 2; ++kk) {
            u32x4 w = {pk2(s[qs][2 * kk][0], s[qs][2 * kk][1]), pk2(s[qs][2 * kk][2], s[qs][2 * kk][3]),
                       pk2(s[qs][2 * kk + 1][0], s[qs][2 * kk + 1][1]), pk2(s[qs][2 * kk + 1][2], s[qs][2 * kk + 1][3])};
            pf[qs][kk] = __builtin_bit_cast(bf16x8, w);
          }
        } else {
          u32x4 z = {0u, 0u, 0u, 0u};
          pf[qs][0] = __builtin_bit_cast(bf16x8, z); pf[qs][1] = pf[qs][0];
        }
      }
      if (t + 1 < nt) issueV(t + 1);
#pragma unroll
      for (int d2 = 0; d2 < 8; d2 += 2) {
        bf16x8 vf[2][2];
#pragma unroll
        for (int dd = 0; dd < 2; ++dd)
#pragma unroll
          for (int kk = 0; kk < 2; ++kk) {
            const char* vp = vb0 + (d2 + dd) * 2176 + kk * 64;
            const u32x2 lo = *(const u32x2*)vp, hi = *(const u32x2*)(vp + 32);
            u32x4 w = {lo[0], lo[1], hi[0], hi[1]};
            vf[dd][kk] = __builtin_bit_cast(bf16x8, w);
          }
#pragma unroll
        for (int dd = 0; dd < 2; ++dd)
#pragma unroll
          for (int kk = 0; kk < 2; ++kk) {
            o[0][d2 + dd] = MFMA16(vf[dd][kk], pf[0][kk], o[0][d2 + dd]);
            if (nsub > 1) o[1][d2 + dd] = MFMA16(vf[dd][kk], pf[1][kk], o[1][d2 + dd]);
          }
        __builtin_amdgcn_sched_barrier(0);
      }
    }
  }
#pragma unroll
  for (int qs = 0; qs < 2; ++qs) {
    if (qs < nsub) {
      float lt = l[qs]; lt += __shfl_xor(lt, 16); lt += __shfl_xor(lt, 32);
      const float inv = 1.f / lt;
      bf16_t* dst = p.mix + (size_t)(qrow0 + qs * 16 + fr) * 1024 + 512 + h * 128 + fq * 4;
#pragma unroll
      for (int d = 0; d < 8; ++d) st_bf4(dst + d * 16, o[qs][d] * inv);
    }
  }
}

DI void fixup_phase(const P& p) {
  const int total = (1024 + 128) * 352, stride = gridDim.x * 256;
  for (int e = blockIdx.x * 256 + get_tid(); e < total; e += stride) {
    const int r = e / 352, c0 = (e - r * 352) * 8;
    const bf16_t *pa0, *pa1 = nullptr, *pa2 = nullptr, *pv; const float *f1 = nullptr, *f2 = nullptr; int row;
    if (r < 1024) {
      const int blk = r >> 1, i = r & 1; row = blk * 64 + i; const int pos = row & 4095;
      pa0 = p.headA + (size_t)r * 2816 + c0; pv = p.headV + (size_t)r * 2816 + c0;
      if (i == 0) { if (pos != 0) { pa1 = p.tailA + ((size_t)(blk - 1) * 2 + 1) * 2816 + c0; pa2 = p.tailA + ((size_t)(blk - 1) * 2) * 2816 + c0; } }
      else { pa1 = p.headA + (size_t)(r - 1) * 2816 + c0; if (pos != 1) pa2 = p.tailA + ((size_t)(blk - 1) * 2 + 1) * 2816 + c0; }
    } else {
      const int sr = r - 1024, b = sr >> 4, i = sr & 15; row = TP + sr;
      pa0 = p.sA + (size_t)sr * 2816 + c0; pv = p.sV + (size_t)sr * 2816 + c0;
      const float* cst = p.st_conv + (size_t)b * 2 * 2816 + c0;
      if (i >= 1) pa1 = pa0 - 2816; else f1 = cst + 2816;
      if (i >= 2) pa2 = pa0 - 2 * 2816; else f2 = cst + i * 2816;
    }
    float a0[8], a1[8], a2[8], vv[8];
    { const u32x4 t = *(const u32x4*)pa0, u = *(const u32x4*)pv;
#pragma unroll
      for (int j = 0; j < 4; ++j) { a0[2 * j] = bflo(t[j]); a0[2 * j + 1] = bfhi(t[j]); vv[2 * j] = bflo(u[j]); vv[2 * j + 1] = bfhi(u[j]); } }
    if (pa1) { const u32x4 t = *(const u32x4*)pa1;
#pragma unroll
      for (int j = 0; j < 4; ++j) { a1[2 * j] = bflo(t[j]); a1[2 * j + 1] = bfhi(t[j]); } }
    else {
#pragma unroll
      for (int j = 0; j < 8; ++j) a1[j] = f1 ? f1[j] : 0.f; }
    if (pa2) { const u32x4 t = *(const u32x4*)pa2;
#pragma unroll
      for (int j = 0; j < 4; ++j) { a2[2 * j] = bflo(t[j]); a2[2 * j + 1] = bfhi(t[j]); } }
    else {
#pragma unroll
      for (int j = 0; j < 8; ++j) a2[j] = f2 ? f2[j] : 0.f; }
    float g[8];
#pragma unroll
    for (int j = 0; j < 8; ++j) {
      const float cv = p.conv_b[c0 + j] + p.conv_w[c0 + j] * a2[j] + p.conv_w[2816 + c0 + j] * a1[j] + p.conv_w[5632 + c0 + j] * a0[j];
      g[j] = gelu_erf(cv) * vv[j];
    }
    u32x4 w = {pk2(g[0], g[1]), pk2(g[2], g[3]), pk2(g[4], g[5]), pk2(g[6], g[7])};
    *(u32x4*)(p.vbuf + (size_t)row * 2816 + c0) = w;
  }
}

constexpr int ATT_ITEMS = 32 + 1024;
constexpr int MT = T / 128, MTK = TK / 128, MT2 = (T + 255) / 256, MTK2 = (TK + 255) / 256;
__global__ void __launch_bounds__(256, 2) fwd_kernel(P p) {
  __shared__ __attribute__((aligned(16))) char lds[65536];
  __shared__ uint4 xb_words;
  cg::grid_group grid = cg::this_grid();
  const unsigned G = gridDim.x;
  if (threadIdx.x == 0) xb_words = make_uint4(0u, 0u, 0u, 0u);
  __syncthreads();
  const XcdBarrier xb = xcd_barrier_post(p.ctr, (volatile LAS unsigned*)&xb_words);
  if (p.ctr[CTR_Q + 40] != 0u) grid.sync();
  for (int rep = 0; rep < REP_P0; ++rep) phase0(p, lds);
  gbar(p.ctr, 0);
  for (int rep = 0; rep < REP_ROW; ++rep) rownorm_phase(p, 0);
  gbar(p.ctr, 0);
  { EpiProj e{p};
    for (int rep = 0; rep < REP_GEMM; ++rep)
    { gemm256_stream<EpiProj, false, false, true>(p.hbuf, 1024, p.WinT, 1024, 1024, MT2, 22, T, lds, e); } }
  { int* s_item = (int*)(lds + 65528);
    for (;;) {
      __syncthreads();
      if (get_tid() == 0) *s_item = (int)atomicAdd(p.ctr + CTR_Q + 2, 1u);
      __syncthreads();
      const int it = *s_item + P0_EARLY;
      if (it >= P0_TOTAL - 1) break;
      p0_item(p, it, lds);
    } }
  gbar(p.ctr, 0);
  for (int rep = 0; rep < REP_P3; ++rep)
  { const int nrow_items = (T + 3) / 4;
    for (int pos = blockIdx.x; pos < 5 * NCH; pos += G) {
      const int a = pos / 5, r = pos - 5 * a;
      if (r == 0) hg1_item(p, a, lds);
      else { const int it = 4 * a + (r - 1); const int row = it * 4 + (get_tid() >> 6); if (it < nrow_items && row < T) post_row(p, row, get_tid() & 63); }
    } }
  gbar(p.ctr, 0);
  { EpiQ eq{p}; EpiKn ek{p}; EpiVt ev{p};
    for (int it = blockIdx.x; it < 1024; it += G) {
#ifndef SKIP_HG2
      hg2_item(p, it);
#endif
    }
    int mt, nt;
    for (int k = 0; tile_next(k, MT, 6, mt, nt); ++k) gemm_tile<EpiQ, false, false, true>(p.cqn, 384, p.WuqT, 384, 384, mt * 128, nt * 128, lds, eq);
    for (int k = 0; tile_next(k, MTK, 4, mt, nt); ++k) gemm_tile<EpiKn, false, false, true>(p.lat_all, 256, p.WukT, 256, 256, mt * 128, nt * 128, lds, ek);
    for (int k = 0; tile_next(k, 4, MTK, mt, nt); ++k) gemm_tile<EpiVt, false, false, true>(p.WuvT, 256, p.lat_all, 256, 256, mt * 128, nt * 128, lds, ev);
  }
  gbar(p.ctr, 0);
  for (int rep = 0; rep < REP_ATT; ++rep)
  { int* s_item = (int*)(lds + 65528);
    const int total = 3 * ATT_ITEMS;
    for (;;) {
      __syncthreads();
      if (get_tid() == 0) *s_item = (int)atomicAdd(p.ctr + CTR_Q + rep, 1u);
      __syncthreads();
      const int pos = *s_item;
      if (pos >= total) break;
      const int a = pos / 3, r = pos - 3 * a;
      if (r == 0) { const int it = a, j = it - 32; const int kind = it < 32 ? 1 : 0;
        attn_item(p, kind, kind ? (it >> 2) : ((j & 31) >> 2), it & 3, kind ? 0 : 31 - (j >> 5), lds); }
      else { const int hid = 2 * a + (r - 1); if (hid < NCH) hg3_item(p, hid, lds); }
    } }
  gbar(p.ctr, 0);
  { EpiOut e{p};
    for (int rep = 0; rep < REP_GEMM; ++rep)
    { gemm256_stream<EpiOut, false, false, true>(p.mix, 1024, p.WoutT, 1024, 1024, 128, 8, T, lds, e);
      for (int it = blockIdx.x; it < 8; it += G) gemm_tile(p.mix, 1024, p.WoutT, 1024, 1024, TP, it * 128, lds, e); } }
  gbar(p.ctr, 0);
  for (int rep = 0; rep < REP_ROW; ++rep) rownorm_phase(p, 1);
  gbar(p.ctr, 0);
  { EpiGlu e{p};
    for (int rep = 0; rep < REP_GEMM; ++rep)
    { gemm256_stream<EpiGlu, true, false, true>(p.hbuf, 1024, p.WupT, 1024, 1024, MT2, 44, T, lds, e); } }
  gbar(p.ctr, 0);
  fixup_phase(p);
  gbar(p.ctr, 0);
  for (int rep = 0; rep < REP_TAIL; ++rep)
  { EpiDown e{p, rep < REP_TAIL - 1 && p.ctr[CTR_Q + 24] == 0};
    { gemm256_stream<EpiDown, false, false, true>(p.vbuf, 2816, p.WdownT, 2816, 2816, 128, 8, T, lds, e);
      for (int it = blockIdx.x; it < 8; it += G) gemm_tile(p.vbuf, 2816, p.WdownT, 2816, 2816, TP, it * 128, lds, e); } }
  gbar(p.ctr, 0);
  for (int rep = 0; rep < REP_TAIL; ++rep) final_phase(p, rep < REP_TAIL - 1 && p.ctr[CTR_Q + 24] == 0);
}

extern "C" void kernel_launch(void* const* d_in, const int* in_sizes, int n_in, void* d_out, int out_size, void* d_ws,
                              size_t ws_size, hipStream_t stream) {
  P p{};
  const float* const* in = (const float* const*)d_in;
  p.x_p = in[0]; p.x_s = in[1]; p.c_p = in[2]; p.c_s = in[3]; p.cache_lat = in[4]; p.cache_kpe = in[5]; p.st_hg = in[6]; p.st_conv = in[7];
  p.w_ada = in[8]; p.b_ada = in[9]; p.g_mix = in[10]; p.w_in = in[11]; p.lb_logits = in[12]; p.hg_gain = in[13]; p.qn_g = in[14]; p.kvn_g = in[15];
  p.w_uq = in[16]; p.w_uk = in[17]; p.w_uv = in[18]; p.w_out = in[19]; p.g_ffn = in[20]; p.w_up = in[21]; p.conv_w = in[22]; p.conv_b = in[23];
  p.w_down = in[24]; p.g_final = in[25];
  p.out = (float*)d_out;
  char* w = (char*)d_ws; size_t off = 0;
  auto take = [&](size_t bytes) { char* r = w + off; off += (bytes + 255) & ~(size_t)255; return r; };
  p.ctr = (unsigned*)take(16384);
  p.mod = (float*)take(16 * 6144 * 4);
  p.lb = (float*)take(4096);
  p.rope = (float*)take((size_t)4112 * 64 * 4);
  p.Dbuf = (float*)take((size_t)NCH * 128 * 4);
  p.WinT = (bf16_t*)take((size_t)2816 * 1024 * 2);
  p.WuqT = (bf16_t*)take((size_t)768 * 384 * 2);
  p.WukT = (bf16_t*)take((size_t)512 * 256 * 2);
  p.WuvT = (bf16_t*)take((size_t)512 * 256 * 2);
  p.WoutT = (bf16_t*)take((size_t)1024 * 1024 * 2);
  p.WupT = (bf16_t*)take((size_t)5632 * 1024 * 2);
  p.WdownT = (bf16_t*)take((size_t)1024 * 2816 * 2);
  p.hbuf = (bf16_t*)take((size_t)T * 1024 * 2);
  p.Q = p.hbuf;
  const size_t big0 = off;
  p.hq = (bf16_t*)take((size_t)T * 512 * 2);
  p.hv = (bf16_t*)take((size_t)T * 512 * 2);
  p.hgs = (bf16_t*)take((size_t)T * 512 * 2);
  p.logf = (float*)take((size_t)T * 512 * 4);
  p.cqn = (bf16_t*)take((size_t)T * 384 * 2);
  p.lat_all = (bf16_t*)take((size_t)TK * 256 * 2);
  p.kpe_all = (bf16_t*)take((size_t)TK * 64 * 2);
  p.dS = (bf16_t*)take((size_t)NCH * 16384 * 2);
  p.mix = (bf16_t*)take((size_t)T * 1024 * 2);
  p.x1b = (bf16_t*)take((size_t)T * 1024 * 2);
  const size_t big1 = off;
  p.abuf = (bf16_t*)(w + big0);
  p.vbuf = p.abuf + (size_t)T * 2816;
  p.headA = p.abuf; p.headV = p.headA + (size_t)1024 * 2816; p.tailA = p.headV + (size_t)1024 * 2816;
  p.sA = p.tailA + (size_t)1024 * 2816; p.sV = p.sA + (size_t)128 * 2816;
  const size_t ffn_end = big0 + (size_t)T * 2816 * 2 * 2;
  const size_t need = ffn_end > big1 ? ffn_end : big1;
  p.mla_raw = (bf16_t*)(p.out + O_Y);
  p.Knope = (bf16_t*)(p.out + O_Y);
  p.Vt = p.Knope + (size_t)TK * 512;
  if (need > ws_size) { fprintf(stderr, "workspace too small: need %zu have %zu\n", need, ws_size); return; }
  static int grid_blocks = 0;
  if (!grid_blocks) {
    int dev = 0, cus = 0, per_cu = 0;
    hipGetDevice(&dev);
    hipDeviceGetAttribute(&cus, hipDeviceAttributeMultiprocessorCount, dev);
    hipOccupancyMaxActiveBlocksPerMultiprocessor(&per_cu, fwd_kernel, 256, 0);
    if (per_cu > 2) per_cu = 2;
    if (per_cu < 1) per_cu = 1;
    grid_blocks = cus * per_cu;
  }
  hipMemsetAsync(p.ctr, 0, 16384, stream);
  void* args[] = {&p};
  hipError_t e = hipLaunchCooperativeKernel((void*)fwd_kernel, dim3(grid_blocks), dim3(256), args, 0, stream);
  if (e != hipSuccess) fprintf(stderr, "cooperative launch failed: %s (grid %d)\n", hipGetErrorString(e), grid_blocks);
}
```
